# Optimizing an MI355X kernel written in HIP

```python
import functools
import jax, jax.numpy as jnp
from jax import lax
import numpy as np

D_MODEL = 2048
BATCH = 8
SEQ = 2048
DEPTH = 1
DEC_BATCH = 32
DEC_SEQ = 64
PAST_LEN = 4096

CHUNK = 64
HEAD_DIM = 64
D_A = D_MODEL // 2
A_HEADS = D_A // HEAD_DIM
R_W = 64
R_A = 64
SHIFT_W = 3 * D_A + R_W + R_A
LNX_EPS = 64e-5
D_B = D_MODEL // 2
Q_HEADS = D_B // HEAD_DIM
KV_HEADS = 4
GROUP = Q_HEADS // KV_HEADS
KV_W = KV_HEADS * HEAD_DIM
WINDOW = 128
WIN_CHUNKS = WINDOW // CHUNK
CACHE_WIN = min(WINDOW, PAST_LEN)
IN_W = SHIFT_W + D_A + D_B + 2 * KV_W + D_B + 2 * D_MODEL
RMS_EPS = 1e-6
NEG_INF = -1e30

kernel_name = 'hybrid_rwkv7_swa_sink_streaming_step'


def rms_norm(x, g):
    x32 = x.astype(jnp.float32)
    y = x32 * lax.rsqrt(jnp.mean(x32 * x32, axis=-1, keepdims=True) + RMS_EPS)
    return (y * g.astype(jnp.float32)).astype(x.dtype)


def project(x, g_norm, w_in):
    h = rms_norm(x, g_norm)
    z = jnp.einsum('btd,de->bte', h, w_in)
    sizes = (SHIFT_W, D_A, D_B, KV_W, KV_W, D_B, D_MODEL, D_MODEL)
    offs = [int(o) for o in np.cumsum(sizes)[:-1]]
    return jnp.split(z, offs, axis=-1)


def rwkv7_branch(p, gate, shift_prev, wkv0, mu, w0, w_w_up, a0, w_a_up, k_k, k_a, r_k, lnx_w, lnx_b):
    bsz, t_len, _ = p.shape
    f32 = jnp.float32
    prev = jnp.concatenate([shift_prev[:, None, :].astype(p.dtype), p[:, :-1]], axis=1)
    xs = p + mu * (prev - p)
    r, k, v, wd, ad = jnp.split(xs, [D_A, 2 * D_A, 3 * D_A, 3 * D_A + R_W], axis=-1)
    w = -jax.nn.softplus(-(w0 + jnp.tanh(wd) @ w_w_up).astype(f32)) - 0.5
    decay = jnp.exp(-jnp.exp(w))
    a = jax.nn.sigmoid((a0 + ad @ w_a_up).astype(f32))
    heads = lambda u: u.astype(f32).reshape(bsz, t_len, A_HEADS, HEAD_DIM)
    r, k, v, decay, a = heads(r), heads(k), heads(v), heads(decay), heads(a)
    kk = k * k_k.astype(f32).reshape(A_HEADS, HEAD_DIM)
    kk = kk / jnp.maximum(jnp.sqrt(jnp.sum(kk * kk, axis=-1, keepdims=True)), 1e-12)
    k = k * (1.0 + (a - 1.0) * k_a.astype(f32).reshape(A_HEADS, HEAD_DIM))
    seq = tuple(jnp.moveaxis(u, 1, 0) for u in (r, decay, k, v, -kk, kk * a))

    def step(S, inp):
        r_t, w_t, k_t, v_t, a_t, b_t = inp
        sa = jnp.einsum('bhij,bhj->bhi', S, a_t)
        S = S * w_t[:, :, None, :] + sa[..., None] * b_t[:, :, None, :] + v_t[..., None] * k_t[:, :, None, :]
        return S, jnp.einsum('bhij,bhj->bhi', S, r_t)

    s_final, y = lax.scan(step, wkv0.astype(f32), seq)
    y = jnp.moveaxis(y, 0, 1)
    mean = jnp.mean(y, axis=-1, keepdims=True)
    var = jnp.mean(jnp.square(y - mean), axis=-1, keepdims=True)
    y = (y - mean) * lax.rsqrt(var + LNX_EPS) * lnx_w.astype(f32).reshape(A_HEADS, HEAD_DIM) \
        + lnx_b.astype(f32).reshape(A_HEADS, HEAD_DIM)
    y = y + jnp.sum(r * k * r_k.astype(f32), axis=-1, keepdims=True) * v
    y = y.reshape(bsz, t_len, D_A).astype(p.dtype) * jax.nn.silu(gate)
    return y, p[:, -1], s_final.astype(wkv0.dtype)


def sink_attention(q, k, v, q_pos, k_pos, sinks):
    s = jnp.einsum('...qhgd,...khd->...hgqk', q, k, preferred_element_type=jnp.float32) * (HEAD_DIM ** -0.5)
    dist = (q_pos[..., :, None] - k_pos[..., None, :]).astype(jnp.float32)
    dchunk = jnp.floor_divide(q_pos, CHUNK)[..., :, None] - jnp.floor_divide(k_pos, CHUNK)[..., None, :]
    visible = (dchunk >= 0) & (dchunk <= WIN_CHUNKS) & (k_pos >= 0)[..., None, :]
    slopes = (2.0 ** (-8.0 * jnp.arange(1, Q_HEADS + 1, dtype=jnp.float32) / Q_HEADS)).reshape(KV_HEADS, GROUP)
    s = s - slopes[:, :, None, None] * jnp.abs(dist)[..., None, None, :, :]
    s = jnp.where(visible[..., None, None, :, :], s, NEG_INF)
    sink = sinks.astype(jnp.float32).reshape(KV_HEADS, GROUP)[:, :, None, None]
    m = jnp.maximum(jnp.max(s, axis=-1, keepdims=True), sink)
    e = jnp.exp(s - m)
    p = e / (jnp.sum(e, axis=-1, keepdims=True) + jnp.exp(sink - m))
    return jnp.einsum('...hgqk,...khd->...qhgd', p.astype(v.dtype), v)


def attn_prompt(q, k, v, sinks):
    bsz, t_len, _ = q.shape
    n_c = t_len // CHUNK
    pad = WIN_CHUNKS * CHUNK
    q = q.reshape(bsz, n_c, CHUNK, KV_HEADS, GROUP, HEAD_DIM)
    k = k.reshape(bsz, t_len, KV_HEADS, HEAD_DIM)
    v = v.reshape(bsz, t_len, KV_HEADS, HEAD_DIM)

    def band(u):
        up = jnp.pad(u, ((0, 0), (pad, 0), (0, 0), (0, 0))).reshape(bsz, n_c + WIN_CHUNKS, CHUNK, KV_HEADS, HEAD_DIM)
        return jnp.concatenate([up[:, i:i + n_c] for i in range(WIN_CHUNKS + 1)], axis=2)

    kp = jnp.arange(-pad, t_len).reshape(n_c + WIN_CHUNKS, CHUNK)
    k_pos = jnp.concatenate([kp[i:i + n_c] for i in range(WIN_CHUNKS + 1)], axis=1)
    q_pos = jnp.arange(t_len).reshape(n_c, CHUNK)
    o = sink_attention(q, band(k), band(v), q_pos, k_pos, sinks)
    return o.reshape(bsz, t_len, D_B), k[:, -CACHE_WIN:], v[:, -CACHE_WIN:]


def attn_sample(q, k, v, sinks, cache_k, cache_v):
    bsz, t_len, _ = q.shape
    q = q.reshape(bsz, t_len, KV_HEADS, GROUP, HEAD_DIM)
    k_all = jnp.concatenate([cache_k.astype(k.dtype), k.reshape(bsz, t_len, KV_HEADS, HEAD_DIM)], axis=1)
    v_all = jnp.concatenate([cache_v.astype(v.dtype), v.reshape(bsz, t_len, KV_HEADS, HEAD_DIM)], axis=1)
    q_pos = PAST_LEN + jnp.arange(t_len)
    k_pos = jnp.concatenate([PAST_LEN - CACHE_WIN + jnp.arange(CACHE_WIN), q_pos])
    o = sink_attention(q, k_all, v_all, q_pos, k_pos, sinks)
    return o.reshape(bsz, t_len, D_B), k_all[:, -CACHE_WIN:], v_all[:, -CACHE_WIN:]


def mixer_layer(x, shift_prev, wkv0, attend, g_norm, w_in, mu, w0, w_w_up, a0, w_a_up, k_k, k_a, r_k,
                lnx_w, lnx_b, p_a, p_b, w_o):
    p_shift, gate_a, q, kb, vb, gate_b, m_a, m_b = project(x, g_norm, w_in)
    y_a, shift_last, wkv_new = rwkv7_branch(p_shift, gate_a, shift_prev, wkv0, mu, w0, w_w_up, a0, w_a_up,
                                            k_k, k_a, r_k, lnx_w, lnx_b)
    o_b, k_rows, v_rows = attend(q, kb, vb)
    y_b = o_b * jax.nn.silu(gate_b)
    merged = jax.nn.sigmoid(m_a) * (y_a @ p_a) + jax.nn.sigmoid(m_b) * (y_b @ p_b)
    return x + merged @ w_o, shift_last, wkv_new, k_rows, v_rows


def setup_inputs(seed: int = 0) -> dict:
    key = jax.random.key(seed)
    ks = jax.random.split(key, 24)
    n = jax.random.normal
    f32 = jnp.float32
    return {
        'x_prompt': n(ks[0], (BATCH, SEQ, D_MODEL), f32),
        'x_sample': n(ks[1], (DEC_BATCH, DEC_SEQ, D_MODEL), f32),
        'state_wkv': 0.5 * n(ks[2], (DEPTH, DEC_BATCH, A_HEADS, HEAD_DIM, HEAD_DIM), f32),
        'state_shift': n(ks[3], (DEPTH, DEC_BATCH, SHIFT_W), f32),
        'cache_k': n(ks[4], (DEPTH, DEC_BATCH, CACHE_WIN, KV_HEADS, HEAD_DIM), f32),
        'cache_v': n(ks[5], (DEPTH, DEC_BATCH, CACHE_WIN, KV_HEADS, HEAD_DIM), f32),
        'g_norm': 1.0 + 0.02 * n(ks[6], (DEPTH, D_MODEL), f32),
        'w_in': n(ks[7], (DEPTH, D_MODEL, IN_W), f32) * D_MODEL ** -0.5,
        'mu_shift': jax.random.uniform(ks[8], (DEPTH, SHIFT_W), f32, 0.2, 0.8),
        'w0': -0.5 + 0.5 * n(ks[9], (DEPTH, D_A), f32),
        'w_w_up': 0.1 * n(ks[10], (DEPTH, R_W, D_A), f32),
        'a0': 0.1 * n(ks[11], (DEPTH, D_A), f32),
        'w_a_up': 0.1 * n(ks[12], (DEPTH, R_A, D_A), f32),
        'k_k': 0.85 + 0.02 * n(ks[13], (DEPTH, D_A), f32),
        'k_a': 1.0 + 0.02 * n(ks[14], (DEPTH, D_A), f32),
        'r_k': 0.1 * n(ks[15], (DEPTH, A_HEADS, HEAD_DIM), f32),
        'lnx_w': 1.0 + 0.02 * n(ks[16], (DEPTH, D_A), f32),
        'lnx_b': 0.02 * n(ks[17], (DEPTH, D_A), f32),
        'sinks': n(ks[18], (DEPTH, Q_HEADS), f32),
        'p_a': n(ks[19], (DEPTH, D_A, D_MODEL), f32) * D_A ** -0.5,
        'p_b': n(ks[20], (DEPTH, D_B, D_MODEL), f32) * D_B ** -0.5,
        'w_o': n(ks[21], (DEPTH, D_MODEL, D_MODEL), f32) * D_MODEL ** -0.5,
        'g_final': 1.0 + 0.02 * n(ks[22], (D_MODEL,), f32),
    }


def reference(x_prompt, x_sample, state_wkv, state_shift, cache_k, cache_v, g_norm, w_in, mu_shift, w0,
              w_w_up, a0, w_a_up, k_k, k_a, r_k, lnx_w, lnx_b, sinks, p_a, p_b, w_o, g_final):
    xp, xs = x_prompt, x_sample
    zero_shift = jnp.zeros((xp.shape[0], SHIFT_W), xp.dtype)
    zero_wkv = jnp.zeros((xp.shape[0], A_HEADS, HEAD_DIM, HEAD_DIM), jnp.float32)
    wkv_p, shift_p, k_p, v_p = [], [], [], []
    wkv_s, shift_s, k_s, v_s = [], [], [], []
    for l in range(DEPTH):
        lw = (g_norm[l], w_in[l], mu_shift[l], w0[l], w_w_up[l], a0[l], w_a_up[l], k_k[l], k_a[l], r_k[l],
              lnx_w[l], lnx_b[l], p_a[l], p_b[l], w_o[l])
        xp, sh, wk, kr, vr = mixer_layer(xp, zero_shift, zero_wkv,
                                         functools.partial(attn_prompt, sinks=sinks[l]), *lw)
        shift_p.append(sh); wkv_p.append(wk); k_p.append(kr); v_p.append(vr)
        xs, sh, wk, kr, vr = mixer_layer(xs, state_shift[l], state_wkv[l],
                                         functools.partial(attn_sample, sinks=sinks[l], cache_k=cache_k[l],
                                                           cache_v=cache_v[l]), *lw)
        shift_s.append(sh); wkv_s.append(wk); k_s.append(kr); v_s.append(vr)
    y_prompt = rms_norm(xp, g_final)
    y_sample = rms_norm(xs, g_final)
    return (y_prompt, y_sample,
            jnp.stack(wkv_p), jnp.stack(shift_p), jnp.stack(k_p), jnp.stack(v_p),
            jnp.stack(wkv_s), jnp.stack(shift_s), jnp.stack(k_s), jnp.stack(v_s))
```

```cpp
#include <hip/hip_runtime.h>
#include <hip/hip_cooperative_groups.h>
#include <cstdio>
#include <cstdint>
namespace cg = cooperative_groups;

#ifndef MK_MULTI
#define MK_MULTI 0
#endif

namespace pg8 {
#define PG8_LAS __attribute__((address_space(3)))
typedef unsigned short bf16_t;
typedef short bf16x8 __attribute__((ext_vector_type(8)));
typedef float f32x4 __attribute__((ext_vector_type(4)));
typedef unsigned u32x4 __attribute__((ext_vector_type(4)));
constexpr int BM = 256, BK = 64, HALF = 128, HTB = HALF * BK * 2, STAGE_BYTES = 8 * HTB, NXCD = 8, WGM = 8;
__host__ __device__ __forceinline__ int lds_byte(int r, int c) { const int st = (r >> 4) * 2 + (c >> 5), rr = r & 15, cc = c & 31, ob = rr * 64 + cc * 2; return st * 1024 + (ob ^ (((ob >> 9) & 1) << 5)); }
__host__ __device__ __forceinline__ void stage_rc(int b, int& R, int& C) { const int st = b / 1024, sb = b % 1024, swz = sb ^ (((sb >> 9) & 1) << 5); R = (st >> 1) * 16 + swz / 64; C = (st & 1) * 32 + (swz % 64) / 2; }
__host__ __device__ __forceinline__ int perm32(int rho) { const int n = rho >> 4, i = rho & 15; return 8 * (i >> 2) + 4 * n + (i & 3); }
struct Unit { int pm, pn; };
struct Gemm { const bf16_t* A; const bf16_t* Bt; int M, N, K, lda; };
struct StaticOrder {
    int nM, nN, nwg, G, c;
    __host__ __device__ void init(int M, int N, int G_, int c_) { nM = M / BM; nN = N / BM; nwg = nM * nN; G = G_; c = c_; }
    __host__ __device__ bool next(int i, Unit& u) const {
        const long L = (long)i * G + c; if (L >= nwg) return false;
        int wgid = (int)L; { const int q = nwg / NXCD, r = nwg % NXCD, xcd = wgid % NXCD, off = wgid / NXCD; wgid = (xcd < r ? xcd * (q + 1) : r * (q + 1) + (xcd - r) * q) + off; }
        const int nig = WGM * nN, gid = wgid / nig, fm = gid * WGM, gsz = (nM - fm) < WGM ? (nM - fm) : WGM;
        u.pm = fm + ((wgid % nig) % gsz); u.pn = (wgid % nig) / gsz; return true;
    }
    __device__ __forceinline__ void a_ready(const Unit&) const {}
    __device__ __forceinline__ void done(const Unit&) const {}
};
__device__ __forceinline__ unsigned cvt_pk_bf16(float lo, float hi) { unsigned r; asm volatile("v_cvt_pk_bf16_f32 %0, %1, %2" : "=v"(r) : "v"(lo), "v"(hi)); return r; }
template <class Epi, class Sched, bool ALIGN_EPI = false, bool SP2 = false>
__device__ __forceinline__ void gemm_phase(PG8_LAS unsigned char* lds, const Gemm g, const Sched& S, const Epi& E) {
    const int tid = threadIdx.x, wid = __builtin_amdgcn_readfirstlane(tid >> 6), lane = tid & 63, wr = wid >> 2, wc = wid & 3, fr = lane & 15, fq = lane >> 4;
    const int K = g.K, nt = K / BK;
    unsigned voffA[2], voffB[2];
#pragma unroll
    for (int i = 0; i < 2; ++i) { int R, C; stage_rc(tid * 16 + i * 8192, R, C); const int Rb = Epi::PERM ? ((R & ~31) + perm32(R & 31)) : R;
        voffA[i] = (unsigned)(R * g.lda + C) * 2u; voffB[i] = (unsigned)(Rb * K + C) * 2u; }
    const size_t kstep = (size_t)(BK * 2);
    const size_t hstepB = (size_t)HALF * K * 2, hstepA = (size_t)HALF * g.lda * 2;
    const size_t tstepB = 2 * hstepB, tstepA = 2 * hstepA;
    const unsigned ldsw = (unsigned)wid * 1024u;
    const int aoff = lds_byte(wr * 64 + fr, fq * 8), boff = lds_byte(wc * 32 + fr, fq * 8);
#define PG8_SA(b, h) (((b) * 2 + (h)) * HTB)
#define PG8_SB(b, h) ((4 + (b) * 2 + (h)) * HTB)
#define PG8_STAGE(bufoff, gbase, voff) do { _Pragma("unroll") for (int _i = 0; _i < 2; ++_i) \
        __builtin_amdgcn_global_load_lds((const unsigned*)((const char*)(gbase) + (voff)[_i]), (PG8_LAS unsigned*)(lds + (bufoff) + ldsw + _i * 8192), 16, 0, 0); } while (0)
#define PG8_LDA(dst, b, h) do { _Pragma("unroll") for (int m = 0; m < 4; ++m) _Pragma("unroll") for (int k = 0; k < 2; ++k) dst[m][k] = *(const PG8_LAS bf16x8*)(lds + PG8_SA(b, h) + aoff + m * 2048 + k * 1024); } while (0)
#define PG8_LDB(dst, b, h) do { _Pragma("unroll") for (int n = 0; n < 2; ++n) _Pragma("unroll") for (int k = 0; k < 2; ++k) dst[n][k] = *(const PG8_LAS bf16x8*)(lds + PG8_SB(b, h) + boff + n * 2048 + k * 1024); } while (0)
#define PG8_MMA(ai, bj, At, Bt) do { __builtin_amdgcn_s_setprio(1); _Pragma("unroll") for (int m = 0; m < 4; ++m) _Pragma("unroll") for (int n = 0; n < 2; ++n) _Pragma("unroll") for (int k = 0; k < 2; ++k) \
        acc[ai][bj][m][n] = __builtin_amdgcn_mfma_f32_16x16x32_bf16(Bt[n][k], At[m][k], acc[ai][bj][m][n], 0, 0, 0); __builtin_amdgcn_s_setprio(0); } while (0)
#define PG8_WAIT_V(n) asm volatile("s_waitcnt vmcnt(" #n ")" ::: "memory")
#define PG8_WAIT_L(n) asm volatile("s_waitcnt lgkmcnt(" #n ")" ::: "memory")
#define PG8_BAR __builtin_amdgcn_s_barrier()
#define PG8_SCHED __builtin_amdgcn_sched_barrier(0)
    Unit cur, nxt; int ui = 0;
    if (!S.next(0, cur)) return;
    f32x4 acc[2][2][4][2];
#pragma unroll
    for (int a = 0; a < 2; ++a)
#pragma unroll
        for (int b = 0; b < 2; ++b)
#pragma unroll
            for (int m = 0; m < 4; ++m)
#pragma unroll
                for (int n = 0; n < 2; ++n) acc[a][b][m][n] = (f32x4){0.f, 0.f, 0.f, 0.f};
    bf16x8 At[4][2], B0[2][2], B1[2][2];
    const char* cA = (const char*)g.A + (size_t)cur.pm * tstepA; const char* cB = (const char*)g.Bt + (size_t)cur.pn * tstepB;
    S.a_ready(cur);
    if constexpr (SP2) {
        PG8_STAGE(PG8_SB(0, 0), cB, voffB); PG8_STAGE(PG8_SB(0, 1), cB + hstepB, voffB); PG8_STAGE(PG8_SA(0, 0), cA, voffA); PG8_STAGE(PG8_SA(0, 1), cA + hstepA, voffA);
        if (wr == 1) PG8_BAR;
        PG8_WAIT_V(2); PG8_BAR;
        PG8_STAGE(PG8_SB(1, 0), cB + kstep, voffB); PG8_STAGE(PG8_SA(1, 0), cA + kstep, voffA); PG8_STAGE(PG8_SB(1, 1), cB + hstepB + kstep, voffB);
        PG8_WAIT_V(6); PG8_BAR;
    } else {
        PG8_STAGE(PG8_SB(0, 0), cB, voffB); PG8_STAGE(PG8_SA(0, 0), cA, voffA); PG8_STAGE(PG8_SB(0, 1), cB + hstepB, voffB); PG8_STAGE(PG8_SA(0, 1), cA + hstepA, voffA);
        if (wr == 1) PG8_BAR;
        PG8_WAIT_V(4); PG8_BAR;
        PG8_STAGE(PG8_SB(1, 0), cB + kstep, voffB); PG8_STAGE(PG8_SA(1, 0), cA + kstep, voffA); PG8_STAGE(PG8_SB(1, 1), cB + hstepB + kstep, voffB);
        PG8_WAIT_V(6); PG8_BAR;
    }
    for (;;) {
        const bool has_next = S.next(ui + 1, nxt);
        const char* nA = has_next ? (const char*)g.A + (size_t)nxt.pm * tstepA : cA; const char* nB = has_next ? (const char*)g.Bt + (size_t)nxt.pn * tstepB : cB;
        for (int t = 0; t < nt; t += 2) {
            const bool last = (t == nt - 2);
            if constexpr (Epi::MIDHOOK) { if (t == nt / 2) { asm volatile("" ::: "memory"); __builtin_amdgcn_sched_barrier(0); E.mid(acc, cur, wr, wc, fr, fq); asm volatile("" ::: "memory"); __builtin_amdgcn_sched_barrier(0); } }
            const char* a1 = cA + (size_t)(t + 1) * kstep;
            const char* a2 = last ? nA : cA + (size_t)(t + 2) * kstep; const char* b2 = last ? nB : cB + (size_t)(t + 2) * kstep;
            const char* a3 = a2 + kstep; const char* b3 = b2 + kstep;
            if (last && has_next) S.a_ready(nxt);
            if constexpr (SP2) {
            PG8_LDB(B0, 0, 0); PG8_LDB(B1, 0, 1); PG8_SCHED; PG8_LDA(At, 0, 0); PG8_STAGE(PG8_SA(1, 1), a1 + hstepA, voffA);
            PG8_WAIT_V(8); PG8_WAIT_L(0); PG8_BAR; PG8_MMA(0, 0, At, B0); PG8_MMA(0, 1, At, B1); PG8_BAR; PG8_SCHED;
            PG8_LDA(At, 0, 1); PG8_STAGE(PG8_SB(0, 0), b2, voffB); PG8_STAGE(PG8_SB(0, 1), b2 + hstepB, voffB); PG8_STAGE(PG8_SA(0, 0), a2, voffA);
            PG8_WAIT_V(8); PG8_WAIT_L(0); PG8_BAR; PG8_MMA(1, 0, At, B0); PG8_MMA(1, 1, At, B1); PG8_BAR; PG8_SCHED;
            PG8_LDB(B0, 1, 0); PG8_LDB(B1, 1, 1); PG8_SCHED; PG8_LDA(At, 1, 0); PG8_STAGE(PG8_SA(0, 1), a2 + hstepA, voffA);
            PG8_WAIT_V(8); PG8_WAIT_L(0); PG8_BAR; PG8_MMA(0, 0, At, B0); PG8_MMA(0, 1, At, B1); PG8_BAR; PG8_SCHED;
            PG8_LDA(At, 1, 1); PG8_STAGE(PG8_SB(1, 0), b3, voffB); PG8_STAGE(PG8_SB(1, 1), b3 + hstepB, voffB); PG8_STAGE(PG8_SA(1, 0), a3, voffA);
            PG8_WAIT_V(8); PG8_WAIT_L(0); PG8_BAR; PG8_MMA(1, 0, At, B0); PG8_MMA(1, 1, At, B1); PG8_BAR; PG8_SCHED;
            } else {
            PG8_LDB(B0, 0, 0); PG8_SCHED; PG8_LDA(At, 0, 0); PG8_STAGE(PG8_SA(1, 1), a1 + hstepA, voffA);
            PG8_WAIT_L(8); PG8_BAR; PG8_WAIT_L(0); PG8_MMA(0, 0, At, B0); PG8_BAR; PG8_SCHED;
            PG8_LDB(B1, 0, 1); PG8_STAGE(PG8_SB(0, 0), b2, voffB);
            PG8_BAR; PG8_WAIT_L(0); PG8_MMA(0, 1, At, B1); PG8_BAR;
            PG8_LDA(At, 0, 1); PG8_STAGE(PG8_SA(0, 0), a2, voffA);
            PG8_BAR; PG8_WAIT_L(0); PG8_MMA(1, 0, At, B0); PG8_BAR; PG8_SCHED;
            PG8_STAGE(PG8_SB(0, 1), b2 + hstepB, voffB);
            PG8_WAIT_V(6); PG8_BAR; PG8_MMA(1, 1, At, B1); PG8_BAR;
            PG8_LDB(B0, 1, 0); PG8_SCHED; PG8_LDA(At, 1, 0); PG8_STAGE(PG8_SA(0, 1), a2 + hstepA, voffA);
            PG8_WAIT_L(8); PG8_BAR; PG8_WAIT_L(0); PG8_MMA(0, 0, At, B0); PG8_BAR; PG8_SCHED;
            PG8_LDB(B1, 1, 1); PG8_STAGE(PG8_SB(1, 0), b3, voffB);
            PG8_BAR; PG8_WAIT_L(0); PG8_MMA(0, 1, At, B1); PG8_BAR;
            PG8_LDA(At, 1, 1); PG8_STAGE(PG8_SA(1, 0), a3, voffA);
            PG8_BAR; PG8_WAIT_L(0); PG8_MMA(1, 0, At, B0); PG8_BAR; PG8_SCHED;
            PG8_STAGE(PG8_SB(1, 1), b3 + hstepB, voffB);
            PG8_WAIT_V(6); PG8_BAR; PG8_MMA(1, 1, At, B1); PG8_BAR;
            }
        }
        if constexpr (ALIGN_EPI) { if (wr == 0) PG8_BAR; }
        if constexpr (!Epi::AFTER_DRAIN) { E(acc, cur, wr, wc, fr, fq); S.done(cur); }
        if (!has_next) break;
#pragma unroll
        for (int a = 0; a < 2; ++a)
#pragma unroll
            for (int b = 0; b < 2; ++b)
#pragma unroll
                for (int m = 0; m < 4; ++m)
#pragma unroll
                    for (int n = 0; n < 2; ++n) acc[a][b][m][n] = (f32x4){0.f, 0.f, 0.f, 0.f};
        cur = nxt; cA = nA; cB = nB; ++ui;
        if constexpr (ALIGN_EPI) { if (wr == 1) PG8_BAR; }
    }
    PG8_WAIT_V(0);
    if constexpr (!ALIGN_EPI) { if (wr == 0) PG8_BAR; }
    PG8_BAR;
    if constexpr (Epi::AFTER_DRAIN) { E.fused(acc, cur, wr, wc, fr, fq, lds, wid, lane); S.done(cur); }
#undef PG8_SA
#undef PG8_SB
#undef PG8_STAGE
#undef PG8_LDA
#undef PG8_LDB
#undef PG8_MMA
#undef PG8_WAIT_V
#undef PG8_WAIT_L
#undef PG8_BAR
#undef PG8_SCHED
}
}

#define LAS __attribute__((address_space(3)))
typedef unsigned short bf16_t;
typedef short bf16x8 __attribute__((ext_vector_type(8)));
typedef float f32x4 __attribute__((ext_vector_type(4)));
typedef float f32x2 __attribute__((ext_vector_type(2)));
typedef unsigned u32x4 __attribute__((ext_vector_type(4)));
typedef unsigned u32x2 __attribute__((ext_vector_type(2)));

constexpr int DM = 2048, NP_TOK = 16384, MTOK = 18432, SHIFT_W = 3200;
constexpr int ZW = 11008;
constexpr int ZR = 0, ZK = 1024, ZV = 2048, ZGA = 3072, ZQ = 4096, ZKB = 5120, ZVB = 5376, ZGB = 5632, ZMA = 6656, ZMB = 8704, ZWD = 10752, ZAD = 10816;
constexpr size_t MiB = 1u << 20;
constexpr size_t WS_WIN = 0, WS_PA = 43 * MiB, WS_PB = 47 * MiB, WS_WO = 51 * MiB, WS_WW = 59 * MiB, WS_WA = 59 * MiB + 131072, WS_BON = 60 * MiB, WS_Z = 64 * MiB;
constexpr size_t WS_END = WS_Z + (size_t)MTOK * ZW * 2;
constexpr size_t WS_BAR = 63 * MiB, BAR_BYTES = 16384;
constexpr int L_MISC = 147200;
constexpr size_t DO_H = 0, DO_YRAW = 0, DO_YA = 72 * MiB, DO_YB = 108 * MiB;
constexpr size_t O_WKVP = 37748736, O_SHP = O_WKVP + 524288, O_KP = O_SHP + 25600, O_VP = O_KP + 262144, O_WKVS = O_VP + 262144, O_SHS = O_WKVS + 2097152, O_KS = O_SHS + 102400, O_VS = O_KS + 1048576, O_END = O_VS + 1048576;
constexpr int LDS_BYTES = 147456;
constexpr int NPHASE = 7;

struct Args { const float* in[23]; float* out; unsigned char* ws; int ph_lo, ph_hi; };

struct Ctx {
    const float *x_prompt, *x_sample, *state_wkv, *state_shift, *cache_k, *cache_v, *g_norm, *w_in, *mu, *w0, *w_w_up, *a0, *w_a_up, *k_k, *k_a, *r_k, *lnx_w, *lnx_b, *sinks, *p_a, *p_b, *w_o, *g_final;
    float* out; unsigned char* ws;
    bf16_t *WinT, *PaT, *PbT, *WoT, *WwT, *WaT, *Z, *H, *Ya, *Yb, *Yraw; float *bonus;
    LAS unsigned char* lds;
    int tid, lane, wave, G, bid;
};

__device__ __forceinline__ float bflo(unsigned u) { return __uint_as_float(u << 16); }
__device__ __forceinline__ float bfhi(unsigned u) { return __uint_as_float(u & 0xffff0000u); }
__device__ __forceinline__ float bf2f(bf16_t b) { return __uint_as_float((unsigned)b << 16); }
__device__ __forceinline__ unsigned pkbf(float lo, float hi) { return pg8::cvt_pk_bf16(lo, hi); }
__device__ __forceinline__ float wave_sum(float v) {
#pragma unroll
    for (int o = 1; o < 64; o <<= 1) v += __shfl_xor(v, o);
    return v;
}
template <int CTRL> __device__ __forceinline__ float dpp_f(float v) { return __builtin_bit_cast(float, __builtin_amdgcn_update_dpp(0, __builtin_bit_cast(int, v), CTRL, 0xF, 0xF, true)); }
__device__ __forceinline__ float rowsum16(float v) {
    v += dpp_f<0xB1>(v);
    v += dpp_f<0x4E>(v);
    v += dpp_f<0x141>(v);
    v += dpp_f<0x140>(v);
    return v;
}
__device__ __forceinline__ float fast_sigmoid(float x) { return __builtin_amdgcn_rcpf(1.f + __expf(-x)); }
__device__ __forceinline__ float fast_silu(float x) { return x * fast_sigmoid(x); }
__device__ __forceinline__ float fast_tanh(float x) { return 1.f - 2.f * __builtin_amdgcn_rcpf(1.f + __expf(2.f * x)); }
__device__ __forceinline__ const float* xrow(const Ctx& C, int m) { return m < NP_TOK ? C.x_prompt + (size_t)m * DM : C.x_sample + (size_t)(m - NP_TOK) * DM; }
#define LDS_WAIT() asm volatile("s_waitcnt lgkmcnt(0)" ::: "memory")

struct TrItem { const float* src; bf16_t* dst; int N, K; bool zero; };
__device__ __forceinline__ TrItem tr_item(const Ctx& C, int it) {
    constexpr int I_IN = 32 * 344, I_P = 16 * 64, I_O = 32 * 64, I_L = 32;
    TrItem t; int r = it; t.zero = false;
    if (r < I_IN) { const int kb = r / 344, nb = r % 344, zc = 32 * nb; const int src = zc < 3072 ? zc : (zc < 10752 ? zc + 128 : (zc < 10880 ? zc - 10752 + 3072 : -1));
        t.N = 10880; t.K = 2048; t.zero = src < 0; t.src = C.w_in + (size_t)(64 * kb) * 10880 + (src < 0 ? 0 : src); t.dst = C.WinT + (size_t)zc * 2048 + 64 * kb; return t; } r -= I_IN;
    if (r < I_P) { t.N = 2048; t.K = 2048; t.src = C.p_a + (size_t)(64 * (r / 64)) * 2048 + 32 * (r % 64); t.dst = C.PaT + (size_t)(32 * (r % 64)) * 2048 + 64 * (r / 64); return t; } r -= I_P;
    if (r < I_P) { t.N = 2048; t.K = 2048; t.src = C.p_b + (size_t)(64 * (r / 64)) * 2048 + 32 * (r % 64); t.dst = C.PaT + (size_t)(32 * (r % 64)) * 2048 + 1024 + 64 * (r / 64); return t; } r -= I_P;
    if (r < I_O) { t.N = 2048; t.K = 2048; t.src = C.w_o + (size_t)(64 * (r / 64)) * 2048 + 32 * (r % 64); t.dst = C.WoT + (size_t)(32 * (r % 64)) * 2048 + 64 * (r / 64); return t; } r -= I_O;
    if (r < I_L) { t.N = 1024; t.K = 64; t.src = C.w_w_up + 32 * r; t.dst = C.WwT + (size_t)(32 * r) * 64; return t; } r -= I_L;
    t.N = 1024; t.K = 64; t.src = C.w_a_up + 32 * r; t.dst = C.WaT + (size_t)(32 * r) * 64; return t;
}
__device__ __forceinline__ void tr_load(const TrItem& t, int lane, float (&v)[32]) {
#pragma unroll
    for (int i = 0; i < 32; ++i) v[i] = t.zero ? 0.f : __builtin_nontemporal_load(t.src + (size_t)(2 * i + (lane >> 5)) * t.N + (lane & 31));
}
__device__ __forceinline__ void tr_store(const TrItem& t, int lane, const float (&v)[32], LAS float* scr) {
#pragma unroll
    for (int i = 0; i < 32; ++i) scr[(2 * i + (lane >> 5)) * 33 + (lane & 31)] = v[i];
    LDS_WAIT(); asm volatile("" ::: "memory");
    const int c = lane & 7;
#pragma unroll
    for (int j = 0; j < 4; ++j) { const int n = (lane >> 3) + 8 * j; const LAS float* s = scr + (8 * c) * 33 + n;
        u32x4 o; o.x = pkbf(s[0 * 33], s[1 * 33]); o.y = pkbf(s[2 * 33], s[3 * 33]); o.z = pkbf(s[4 * 33], s[5 * 33]); o.w = pkbf(s[6 * 33], s[7 * 33]);
        *(u32x4*)(t.dst + (size_t)n * t.K + 8 * c) = o; }
    LDS_WAIT(); asm volatile("" ::: "memory");
}
__device__ __forceinline__ void tr_run(const Ctx& C, LAS float* scr, int w0, int nw, int set) {
    constexpr int I_IN = 32 * 344, I_MID = 2 * 16 * 64 + 32 * 64, I_L = 2 * 32;
    const int n = set == 0 ? I_IN + I_L : I_MID;
    float va[32], vb[32]; int it = w0;
    if (it >= n) return;
#define TR_ID(i) (set == 0 ? ((i) < I_IN ? (i) : (i) + I_MID) : (i) + I_IN)
    TrItem ta = tr_item(C, TR_ID(it)); tr_load(ta, C.lane, va);
    for (;;) { const int itn = it + nw; const bool more = itn < n; TrItem tb = ta;
        if (more) { tb = tr_item(C, TR_ID(itn)); tr_load(tb, C.lane, vb); }
        tr_store(ta, C.lane, va, scr);
        if (!more) break;
#pragma unroll
        for (int i = 0; i < 32; ++i) va[i] = vb[i];
        ta = tb; it = itn; }
#undef TR_ID
}
__device__ __forceinline__ void phase0(const Ctx& C) {
    LAS float* scr = (LAS float*)(C.lds + C.wave * 16384);
    const int gw = C.bid * 8 + C.wave, NGW = C.G * 8;
    tr_run(C, scr, gw, NGW, 0);
    {
      int m = gw; f32x4 v[8], vn[8];
      if (m < MTOK) { const f32x4* xr = (const f32x4*)xrow(C, m) + C.lane;
#pragma unroll
          for (int j = 0; j < 8; ++j) v[j] = __builtin_nontemporal_load(xr + 64 * j);
          for (;;) { const int mn = m + NGW; const bool more = mn < MTOK;
              if (more) { const f32x4* xn = (const f32x4*)xrow(C, mn) + C.lane;
#pragma unroll
                  for (int j = 0; j < 8; ++j) vn[j] = __builtin_nontemporal_load(xn + 64 * j); }
              float s = 0.f;
#pragma unroll
              for (int j = 0; j < 8; ++j) s += (v[j].x * v[j].x + v[j].y * v[j].y) + (v[j].z * v[j].z + v[j].w * v[j].w);
              const float rs = rsqrtf(wave_sum(s) * (1.f / DM) + 1e-6f);
              u32x2* o8 = (u32x2*)(C.H + (size_t)m * DM) + C.lane; const f32x4* gr = (const f32x4*)C.g_norm + C.lane;
#pragma unroll
              for (int j = 0; j < 8; ++j) { const f32x4 g = gr[64 * j]; u32x2 w; w.x = pkbf(v[j].x * rs * g.x, v[j].y * rs * g.y); w.y = pkbf(v[j].z * rs * g.z, v[j].w * rs * g.w); o8[64 * j] = w; }
              if (!more) break;
#pragma unroll
              for (int j = 0; j < 8; ++j) v[j] = vn[j];
              m = mn; } } }
}

struct EpiZ {
    static constexpr bool PERM = true, AFTER_DRAIN = false, MIDHOOK = false;
    bf16_t* Z;
    __device__ __forceinline__ void operator()(const f32x4 (&acc)[2][2][4][2], const pg8::Unit& u, int wr, int wc, int fr, int fq) const {
        const int pn = u.pn; const int act = (pn >= 12 && pn < 16) || (pn >= 22 && pn < 26) ? 1 : ((pn >= 26 && pn < 42) ? 2 : ((pn >= 16 && pn < 20) ? 3 : 0));
        const int row0 = u.pm * 256 + wr * 64 + fr, col0 = pn * 256 + wc * 32 + 8 * fq;
#pragma unroll
        for (int ai = 0; ai < 2; ++ai)
#pragma unroll
            for (int m = 0; m < 4; ++m) { bf16_t* rowp = Z + (size_t)(row0 + ai * 128 + m * 16) * ZW + col0;
#pragma unroll
                for (int bj = 0; bj < 2; ++bj) { f32x4 v0 = acc[ai][bj][m][0], v1 = acc[ai][bj][m][1];
                    if (act == 1) {
#pragma unroll
                        for (int e = 0; e < 4; ++e) { v0[e] = fast_silu(v0[e]); v1[e] = fast_silu(v1[e]); } }
                    else if (act == 2) {
#pragma unroll
                        for (int e = 0; e < 4; ++e) { v0[e] = fast_sigmoid(v0[e]); v1[e] = fast_sigmoid(v1[e]); } }
                    else if (act == 3) { v0 = v0 * 0.125f; v1 = v1 * 0.125f; }
                    if (act == 2) {
                        unsigned lo = 0u, hi = 0u;
                        lo = __builtin_amdgcn_cvt_pk_u8_f32(__builtin_rintf(v0[0] * 255.f), 0, lo); lo = __builtin_amdgcn_cvt_pk_u8_f32(__builtin_rintf(v0[1] * 255.f), 1, lo); lo = __builtin_amdgcn_cvt_pk_u8_f32(__builtin_rintf(v0[2] * 255.f), 2, lo); lo = __builtin_amdgcn_cvt_pk_u8_f32(__builtin_rintf(v0[3] * 255.f), 3, lo);
                        hi = __builtin_amdgcn_cvt_pk_u8_f32(__builtin_rintf(v1[0] * 255.f), 0, hi); hi = __builtin_amdgcn_cvt_pk_u8_f32(__builtin_rintf(v1[1] * 255.f), 1, hi); hi = __builtin_amdgcn_cvt_pk_u8_f32(__builtin_rintf(v1[2] * 255.f), 2, hi); hi = __builtin_amdgcn_cvt_pk_u8_f32(__builtin_rintf(v1[3] * 255.f), 3, hi);
                        unsigned char* gb = (unsigned char*)(Z + (size_t)(row0 + ai * 128 + m * 16) * ZW + ZMA) + (pn >= 34 ? 2048 + (pn - 34) * 256 : (pn - 26) * 256) + wc * 32 + 8 * fq + bj * 128;
                        *(u32x2*)gb = (u32x2){lo, hi};
                    } else {
                    u32x4 w; w.x = pkbf(v0[0], v0[1]); w.y = pkbf(v0[2], v0[3]); w.z = pkbf(v1[0], v1[1]); w.w = pkbf(v1[2], v1[3]);
                    *(u32x4*)(rowp + bj * 128) = w; } } }
    }
};
template <int PASS> struct EpiMerge {
    static constexpr bool PERM = true, AFTER_DRAIN = false, MIDHOOK = false;
    bf16_t* Z;
    __device__ __forceinline__ void operator()(const f32x4 (&acc)[2][2][4][2], const pg8::Unit& u, int wr, int wc, int fr, int fq) const {
        const int row0 = u.pm * 256 + wr * 64 + fr, col0 = u.pn * 256 + wc * 32 + 8 * fq;
#pragma unroll
        for (int ai = 0; ai < 2; ++ai)
#pragma unroll
            for (int m = 0; m < 4; ++m) { bf16_t* rowz = Z + (size_t)(row0 + ai * 128 + m * 16) * ZW; const unsigned char* gb = (const unsigned char*)(rowz + ZMA) + (PASS ? 2048 : 0) + col0; bf16_t* rowp = rowz + ZMB + col0;
#pragma unroll
                for (int bj = 0; bj < 2; ++bj) { const f32x4 v0 = acc[ai][bj][m][0], v1 = acc[ai][bj][m][1];
                    const u32x2 g8 = __builtin_nontemporal_load((const u32x2*)(gb + bj * 128)); const float k = 1.f / 255.f; float r[8];
                    const float g0 = (float)((g8.x >> 0) & 0xffu) * k, g1 = (float)((g8.x >> 8) & 0xffu) * k, g2 = (float)((g8.x >> 16) & 0xffu) * k, g3 = (float)((g8.x >> 24) & 0xffu) * k;
                    const float g4 = (float)((g8.y >> 0) & 0xffu) * k, g5 = (float)((g8.y >> 8) & 0xffu) * k, g6 = (float)((g8.y >> 16) & 0xffu) * k, g7 = (float)((g8.y >> 24) & 0xffu) * k;
                    if (PASS == 0) {
                        r[0] = g0 * v0[0]; r[1] = g1 * v0[1]; r[2] = g2 * v0[2]; r[3] = g3 * v0[3]; r[4] = g4 * v1[0]; r[5] = g5 * v1[1]; r[6] = g6 * v1[2]; r[7] = g7 * v1[3];
                    } else {
                        const u32x4 t = *(const u32x4*)(rowp + bj * 128);
                        r[0] = bflo(t.x) + g0 * v0[0]; r[1] = bfhi(t.x) + g1 * v0[1]; r[2] = bflo(t.y) + g2 * v0[2]; r[3] = bfhi(t.y) + g3 * v0[3];
                        r[4] = bflo(t.z) + g4 * v1[0]; r[5] = bfhi(t.z) + g5 * v1[1]; r[6] = bflo(t.w) + g6 * v1[2]; r[7] = bfhi(t.w) + g7 * v1[3];
                    }
                    u32x4 w; w.x = pkbf(r[0], r[1]); w.y = pkbf(r[2], r[3]); w.z = pkbf(r[4], r[5]); w.w = pkbf(r[6], r[7]);
                    *(u32x4*)(rowp + bj * 128) = w; } }
    }
};
struct EpiMergeK {
    static constexpr bool PERM = true, AFTER_DRAIN = false, MIDHOOK = true;
    bf16_t* Z;
    __device__ __forceinline__ void mid(f32x4 (&acc)[2][2][4][2], const pg8::Unit& u, int wr, int wc, int fr, int fq) const {
        unsigned off = (unsigned)((u.pm * 256 + wr * 64 + fr) * ZW + ZMA) * 2u + (unsigned)(u.pn * 256 + wc * 32 + 8 * fq);
        const unsigned char* zb = (const unsigned char*)Z;
#pragma unroll
        for (int ai = 0; ai < 2; ++ai)
#pragma unroll
            for (int m = 0; m < 4; ++m) {
#pragma unroll
                for (int bj = 0; bj < 2; ++bj) { asm volatile("" : "+v"(off));
                    const unsigned o2 = off + (unsigned)((ai * 128 + m * 16) * ZW * 2 + bj * 128);
                    const u32x2 a8 = __builtin_nontemporal_load((const u32x2*)(zb + o2)), b8 = *(const u32x2*)(zb + o2 + 2048);
#pragma unroll
                    for (int e = 0; e < 4; ++e) { const float ga0 = (float)((a8.x >> (8 * e)) & 0xffu), gb0 = fmaxf((float)((b8.x >> (8 * e)) & 0xffu), 1.f), ga1 = (float)((a8.y >> (8 * e)) & 0xffu), gb1 = fmaxf((float)((b8.y >> (8 * e)) & 0xffu), 1.f);
                        acc[ai][bj][m][0][e] *= ga0 * __builtin_amdgcn_rcpf(gb0); acc[ai][bj][m][1][e] *= ga1 * __builtin_amdgcn_rcpf(gb1); }
                    asm volatile("" ::: "memory"); } }
    }
    __device__ __forceinline__ void operator()(const f32x4 (&acc)[2][2][4][2], const pg8::Unit& u, int wr, int wc, int fr, int fq) const {
        const int row0 = u.pm * 256 + wr * 64 + fr, col0 = u.pn * 256 + wc * 32 + 8 * fq;
#pragma unroll
        for (int ai = 0; ai < 2; ++ai)
#pragma unroll
            for (int m = 0; m < 4; ++m) { bf16_t* rowz = Z + (size_t)(row0 + ai * 128 + m * 16) * ZW; const unsigned char* gb = (const unsigned char*)(rowz + ZMA) + 2048 + col0; bf16_t* rowp = rowz + ZMB + col0;
#pragma unroll
                for (int bj = 0; bj < 2; ++bj) { const f32x4 v0 = acc[ai][bj][m][0], v1 = acc[ai][bj][m][1]; const u32x2 b8 = *(const u32x2*)(gb + bj * 128); const float k = 1.f / 255.f; float r[8];
#pragma unroll
                    for (int e = 0; e < 4; ++e) { r[e] = v0[e] * (fmaxf((float)((b8.x >> (8 * e)) & 0xffu), 1.f) * k); r[4 + e] = v1[e] * (fmaxf((float)((b8.y >> (8 * e)) & 0xffu), 1.f) * k); }
                    u32x4 w; w.x = pkbf(r[0], r[1]); w.y = pkbf(r[2], r[3]); w.z = pkbf(r[4], r[5]); w.w = pkbf(r[6], r[7]);
                    *(u32x4*)(rowp + bj * 128) = w; } }
    }
};
struct EpiOut {
    static constexpr bool PERM = true, AFTER_DRAIN = false, MIDHOOK = false;
    const float* xp; const float* xs; float* out;
    __device__ __forceinline__ void operator()(const f32x4 (&acc)[2][2][4][2], const pg8::Unit& u, int wr, int wc, int fr, int fq) const {
        const int row0 = u.pm * 256 + wr * 64 + fr, col0 = u.pn * 256 + wc * 32 + 8 * fq;
#pragma unroll
        for (int ai = 0; ai < 2; ++ai)
#pragma unroll
            for (int m = 0; m < 4; ++m) { const int row = row0 + ai * 128 + m * 16;
                const float* xr = (row < NP_TOK ? xp + (size_t)row * DM : xs + (size_t)(row - NP_TOK) * DM) + col0; bf16_t* orow = (bf16_t*)(out + (size_t)row * DM) + col0;
#pragma unroll
                for (int bj = 0; bj < 2; ++bj) { const f32x4 v0 = __builtin_nontemporal_load((const f32x4*)(xr + bj * 128)) + acc[ai][bj][m][0], v1 = __builtin_nontemporal_load((const f32x4*)(xr + bj * 128 + 4)) + acc[ai][bj][m][1];
                    u32x4 w; w.x = pkbf(v0[0], v0[1]); w.y = pkbf(v0[2], v0[3]); w.z = pkbf(v1[0], v1[1]); w.w = pkbf(v1[2], v1[3]);
                    *(u32x4*)(orow + bj * 128) = w; } }
    }
};

constexpr int L_MU = 125184, L_KC = 126464, L_T = 127232, L_GT = 129280;
constexpr int TS = 384;
constexpr int L_R = 0, L_K = 256, L_V = 512, L_W = 768, L_A = 1024, L_B = 1280, L_TW = 98304, L_AD = 107520, L_Y = 116736, L_BON = 124928;
struct ScanOps { f32x4 a, b, k, r; float v; };
__device__ __forceinline__ void swap16(float& a, float& b) { asm("s_nop 1\n\tv_permlane16_swap_b32 %0, %1" : "+v"(a), "+v"(b)); }
__device__ __forceinline__ float swap16_sum_rows(f32x2 p) {
    float x = p.x, y = p.y; swap16(x, y);
    return rowsum16(x + y);
}
__device__ __forceinline__ f32x2 swap16_sum_bcast(f32x2 p) {
    const float s = swap16_sum_rows(p);
    float x = s, y = s; swap16(x, y);
    return (f32x2){x, y};
}
__device__ __forceinline__ void copy_outputs(const Ctx& C) {
    const int gt = C.bid * 512 + C.tid, NGT = C.G * 512;
    for (int e = gt; e < 8 * SHIFT_W; e += NGT) { const int b = e / SHIFT_W, c = e % SHIFT_W; C.out[O_SHP + e] = bf2f(C.Z[((size_t)b * 2048 + 2047) * ZW + (c < 3072 ? c : ZWD + c - 3072)]); }
    for (int e = gt; e < 32 * SHIFT_W; e += NGT) { const int b = e / SHIFT_W, c = e % SHIFT_W; C.out[O_SHS + e] = bf2f(C.Z[((size_t)NP_TOK + b * 64 + 63) * ZW + (c < 3072 ? c : ZWD + c - 3072)]); }
    for (int e4 = gt; e4 < 8 * 128 * 64; e4 += NGT) { const int e = e4 * 4, b = e >> 15, j = (e >> 8) & 127, c = e & 255; const bf16_t* zr = C.Z + ((size_t)b * 2048 + 1920 + j) * ZW;
        const u32x2 k2 = *(const u32x2*)(zr + ZKB + c), v2 = *(const u32x2*)(zr + ZVB + c);
        *(f32x4*)(C.out + O_KP + e) = (f32x4){bflo(k2.x), bfhi(k2.x), bflo(k2.y), bfhi(k2.y)}; *(f32x4*)(C.out + O_VP + e) = (f32x4){bflo(v2.x), bfhi(v2.x), bflo(v2.y), bfhi(v2.y)}; }
    for (int e4 = gt; e4 < 32 * 128 * 64; e4 += NGT) { const int e = e4 * 4, b = e >> 15, j = (e >> 8) & 127, c = e & 255;
        if (j < 64) { *(f32x4*)(C.out + O_KS + e) = *(const f32x4*)(C.cache_k + ((size_t)b * 128 + 64 + j) * 256 + c); *(f32x4*)(C.out + O_VS + e) = *(const f32x4*)(C.cache_v + ((size_t)b * 128 + 64 + j) * 256 + c); }
        else { const bf16_t* zr = C.Z + ((size_t)NP_TOK + b * 64 + (j - 64)) * ZW; const u32x2 k2 = *(const u32x2*)(zr + ZKB + c), v2 = *(const u32x2*)(zr + ZVB + c);
            *(f32x4*)(C.out + O_KS + e) = (f32x4){bflo(k2.x), bfhi(k2.x), bflo(k2.y), bfhi(k2.y)}; *(f32x4*)(C.out + O_VS + e) = (f32x4){bflo(v2.x), bfhi(v2.x), bflo(v2.y), bfhi(v2.y)}; } }
}
struct ScanPre { u32x4 cu[5]; u32x4 pu[5]; };
__device__ __forceinline__ void scan_phase(const Ctx& C) {
    const int tid = C.tid, lane = C.lane, wave = C.wave;
    copy_outputs(C);
    LAS float* sR = (LAS float*)(C.lds + L_R); LAS float* sK = (LAS float*)(C.lds + L_K); LAS float* sV = (LAS float*)(C.lds + L_V);
    LAS float* sW = (LAS float*)(C.lds + L_W); LAS float* sA = (LAS float*)(C.lds + L_A); LAS float* sB = (LAS float*)(C.lds + L_B);
    LAS bf16_t* sTW = (LAS bf16_t*)(C.lds + L_TW); LAS bf16_t* sAD = (LAS bf16_t*)(C.lds + L_AD);
    LAS float* sY = (LAS float*)(C.lds + L_Y); LAS float* sBON = (LAS float*)(C.lds + L_BON);
    for (int it = C.bid; it < 1280; it += C.G) {
        const bool sample = it >= 256; const int s_ = sample ? it - 256 : it;
        const int b = s_ >> 5, h = (s_ >> 1) & 15, half = s_ & 1;
        const int nchunk = sample ? 1 : 32; const size_t row0 = sample ? (size_t)NP_TOK + (size_t)b * 64 : (size_t)b * 2048;
        const int g = lane >> 4, jq = lane & 15, il = 4 * wave + g, i = half * 32 + il;
        float s0 = 0.f, s1 = 0.f, s2 = 0.f, s3 = 0.f;
        if (sample) { const f32x4 r0 = *(const f32x4*)(C.state_wkv + ((size_t)(b * 16 + h) * 64 + i) * 64 + 4 * jq); s0 = r0.x; s1 = r0.y; s2 = r0.z; s3 = r0.w; }
        const int tt = tid >> 3, c8 = (tid & 7) * 8;
        ScanPre pre;
        { LAS float* smu = (LAS float*)(C.lds + L_MU); LAS float* skc = (LAS float*)(C.lds + L_KC);
          if (tid < 320) { const int arr = tid >> 6, c = tid & 63; smu[tid] = C.mu[arr < 3 ? arr * 1024 + h * 64 + c : (arr == 3 ? 3072 + c : 3136 + c)]; }
          else if (tid < 384) skc[tid - 320] = C.k_k[h * 64 + (tid - 320)];
          else if (tid < 448) skc[tid - 320] = C.k_a[h * 64 + (tid - 384)];
          else skc[tid - 320] = C.r_k[h * 64 + (tid - 448)]; }
        const int mat_ = wave >> 2, fr_ = lane & 15, fq_ = lane >> 4;
        bf16x8 lw0[4], lw1[4]; float lbias[4];
        { const bf16_t* wt = (mat_ ? C.WaT : C.WwT) + (size_t)(h * 64 + fr_) * 64 + 8 * fq_; const float* bias = (mat_ ? C.a0 : C.w0) + h * 64 + fr_;
#pragma unroll
          for (int nt = 0; nt < 4; ++nt) { lw0[nt] = *(const bf16x8*)(wt + nt * 16 * 64); lw1[nt] = *(const bf16x8*)(wt + nt * 16 * 64 + 32); lbias[nt] = bias[nt * 16]; } }
#define SCAN_ISSUE_AT(ROW0, HH, CH) do { const int t_ = (CH) * 64 + tt; const bf16_t* zr_ = C.Z + ((ROW0) + t_) * ZW; \
            _Pragma("unroll") for (int arr = 0; arr < 5; ++arr) { const int zcol = arr < 3 ? arr * 1024 + (HH) * 64 + c8 : (arr == 3 ? ZWD + c8 : ZAD + c8); \
                pre.cu[arr] = *(const u32x4*)(zr_ + zcol); pre.pu[arr] = t_ > 0 ? *(const u32x4*)(zr_ - ZW + zcol) : (u32x4){0u, 0u, 0u, 0u}; } } while (0)
#define SCAN_ISSUE(CH) SCAN_ISSUE_AT(row0, h, CH)
        if (it == C.bid) SCAN_ISSUE(0);
        __syncthreads();
        for (int ch = 0; ch < nchunk; ++ch) {
            { const int t = ch * 64 + tt;
#pragma unroll
              for (int arr = 0; arr < 5; ++arr) {
                  const int zcol = arr < 3 ? arr * 1024 + h * 64 + c8 : (arr == 3 ? ZWD + c8 : ZAD + c8);
                  const int ocol = arr < 3 ? zcol : (arr == 3 ? 3072 + c8 : 3136 + c8);
                  const u32x4 cu = pre.cu[arr], pu = pre.pu[arr]; float p[8], pv[8];
                  p[0] = bflo(cu.x); p[1] = bfhi(cu.x); p[2] = bflo(cu.y); p[3] = bfhi(cu.y); p[4] = bflo(cu.z); p[5] = bfhi(cu.z); p[6] = bflo(cu.w); p[7] = bfhi(cu.w);
                  pv[0] = bflo(pu.x); pv[1] = bfhi(pu.x); pv[2] = bflo(pu.y); pv[3] = bfhi(pu.y); pv[4] = bflo(pu.z); pv[5] = bfhi(pu.z); pv[6] = bflo(pu.w); pv[7] = bfhi(pu.w);
                  if (t == 0 && sample) { const f32x4 s0 = *(const f32x4*)(C.state_shift + (size_t)b * SHIFT_W + ocol), s1 = *(const f32x4*)(C.state_shift + (size_t)b * SHIFT_W + ocol + 4);
                      pv[0] = s0.x; pv[1] = s0.y; pv[2] = s0.z; pv[3] = s0.w; pv[4] = s1.x; pv[5] = s1.y; pv[6] = s1.z; pv[7] = s1.w; }
                  const f32x4 m0 = *(const LAS f32x4*)(C.lds + L_MU + (arr * 64 + c8) * 4), m1 = *(const LAS f32x4*)(C.lds + L_MU + (arr * 64 + c8 + 4) * 4);
                  const float mu[8] = {m0.x, m0.y, m0.z, m0.w, m1.x, m1.y, m1.z, m1.w}; float xs[8];
#pragma unroll
                  for (int e = 0; e < 8; ++e) xs[e] = p[e] + mu[e] * (pv[e] - p[e]);
                  if (arr < 3) { LAS float* d = (arr == 0 ? sR : (arr == 1 ? sK : sV)) + tt * TS + c8;
                      *(LAS f32x4*)d = (f32x4){xs[0], xs[1], xs[2], xs[3]}; *(LAS f32x4*)(d + 4) = (f32x4){xs[4], xs[5], xs[6], xs[7]}; }
                  else { if (arr == 3) {
#pragma unroll
                          for (int e = 0; e < 8; ++e) xs[e] = fast_tanh(xs[e]); }
                      u32x4 w; w.x = pkbf(xs[0], xs[1]); w.y = pkbf(xs[2], xs[3]); w.z = pkbf(xs[4], xs[5]); w.w = pkbf(xs[6], xs[7]);
                      *(LAS u32x4*)((arr == 3 ? sTW : sAD) + tt * 72 + c8) = w; }
              } }
            if (ch + 1 < nchunk) SCAN_ISSUE(ch + 1);
            else if (it + C.G < 1280) { const int itn = it + C.G; const bool smp = itn >= 256; const int sn = smp ? itn - 256 : itn; const int nb = sn >> 5, nh = (sn >> 1) & 15;
                const size_t nrow0 = smp ? (size_t)NP_TOK + (size_t)nb * 64 : (size_t)nb * 2048; SCAN_ISSUE_AT(nrow0, nh, 0); }
            __syncthreads();
            { const int mat = wave >> 2, mt = wave & 3, fr = lane & 15, fq = lane >> 4;
              const LAS bf16_t* src = (mat ? sAD : sTW) + (16 * mt + fr) * 72 + 8 * fq;
              const bf16x8 a0f = *(const LAS bf16x8*)src, a1f = *(const LAS bf16x8*)(src + 32);
#pragma unroll
              for (int nt = 0; nt < 4; ++nt) {
                  const bf16x8 b0f = lw0[nt], b1f = lw1[nt];
                  f32x4 acc = (f32x4){0.f, 0.f, 0.f, 0.f};
                  acc = __builtin_amdgcn_mfma_f32_16x16x32_bf16(a0f, b0f, acc, 0, 0, 0);
                  acc = __builtin_amdgcn_mfma_f32_16x16x32_bf16(a1f, b1f, acc, 0, 0, 0);
                  const float bs = lbias[nt]; const int chn = 16 * nt + fr;
#pragma unroll
                  for (int j = 0; j < 4; ++j) { const int tok = 16 * mt + 4 * fq + j; const float pre_ = bs + acc[j]; float o;
                      if (mat == 0) o = __expf(-0.60653065971f * fast_sigmoid(pre_));
                      else o = fast_sigmoid(pre_);
                      (mat ? sB : sW)[tok * TS + chn] = o; } } }
            __syncthreads();
            { LAS float* sT = (LAS float*)(C.lds + L_T); float gacc = 1.f;
#pragma unroll
              for (int i8 = 0; i8 < 8; ++i8) { const int o = (8 * wave + i8) * TS + lane; gacc *= sW[o]; sW[o] = gacc; }
              sT[wave * 64 + lane] = gacc; }
            __syncthreads();
            { const int cq = lane & 15; const f32x4 kkc = *(const LAS f32x4*)(C.lds + L_KC + 16 * cq), kac = *(const LAS f32x4*)(C.lds + L_KC + 256 + 16 * cq), rkc = *(const LAS f32x4*)(C.lds + L_KC + 512 + 16 * cq);
              const LAS float* sT = (const LAS float*)(C.lds + L_T); f32x4 P = (f32x4){1.f, 1.f, 1.f, 1.f};
              for (int w2 = 0; w2 < wave; ++w2) P = P * *(const LAS f32x4*)(sT + w2 * 64 + 4 * cq);
              if (wave == 7 && lane < 16) *(LAS f32x4*)(C.lds + L_GT + 16 * cq) = P * *(const LAS f32x4*)(sT + 7 * 64 + 4 * cq);
#pragma unroll
              for (int i2 = 0; i2 < 2; ++i2) { const int tok = 8 * wave + 4 * i2 + (lane >> 4), o = tok * TS + 4 * cq;
                  const f32x4 ks = *(const LAS f32x4*)(sK + o), al = *(const LAS f32x4*)(sB + o), r = *(const LAS f32x4*)(sR + o); const f32x4 kkr = ks * kkc;
                  const f32x4 gt = *(const LAS f32x4*)(sW + o) * P; f32x4 gp = P; if (tok & 7) gp = *(const LAS f32x4*)(sW + o - TS) * P;
                  const float n2 = rowsum16((kkr.x * kkr.x + kkr.y * kkr.y) + (kkr.z * kkr.z + kkr.w * kkr.w)); const float inv = 1.f / fmaxf(sqrtf(n2), 1e-12f); const f32x4 kk = kkr * inv;
                  const f32x4 kp = ks * (1.f + (al - 1.f) * kac);
                  const f32x4 igt = (f32x4){__builtin_amdgcn_rcpf(gt.x), __builtin_amdgcn_rcpf(gt.y), __builtin_amdgcn_rcpf(gt.z), __builtin_amdgcn_rcpf(gt.w)};
                  *(LAS f32x4*)(sA + o) = -kk * gp; *(LAS f32x4*)(sB + o) = kk * al * igt; *(LAS f32x4*)(sK + o) = kp * igt; *(LAS f32x4*)(sR + o) = r * gt;
                  const f32x4 rk = r * kp * rkc; const float bon = rowsum16((rk.x + rk.y) + (rk.z + rk.w)); if (cq == 0) sBON[tok] = bon; } }
            __syncthreads();
            { const LAS float* pb = sR + 4 * jq; const LAS float* pv = sV + i; LAS float* pY = sY + il;
#define SCAN_LOAD(o, t) do { o.r = *(const LAS f32x4*)(pb + (t) * TS); o.k = *(const LAS f32x4*)(pb + (t) * TS + 64); \
                  o.a = *(const LAS f32x4*)(pb + (t) * TS + 256); o.b = *(const LAS f32x4*)(pb + (t) * TS + 320); o.v = pv[(t) * TS]; } while (0)
#define VMUL(d, x, y) asm("v_mul_f32 %0, %1, %2" : "=v"(d) : "v"(x), "v"(y))
#define VFMA(d, x, y, z) asm("v_fma_f32 %0, %1, %2, %3" : "=v"(d) : "v"(x), "v"(y), "v"(z))
              ScanOps cur, nx1; SCAN_LOAD(cur, 0); SCAN_LOAD(nx1, 1);
              const bool hi8 = (jq & 8) != 0, hi4 = (jq & 4) != 0; LAS float* pYq = sY + il + 32 * (((jq >> 2) & 1) * 2 + (jq >> 3));
#define SCAN_STEP(QV, TT) do { ScanOps nxt; const int tn = (TT) < 62 ? (TT) + 2 : 63; SCAN_LOAD(nxt, tn); \
                  float p; VMUL(p, s0, cur.a.x); VFMA(p, s1, cur.a.y, p); VFMA(p, s2, cur.a.z, p); VFMA(p, s3, cur.a.w, p); \
                  float u0, u1, u2, u3; \
                  VFMA(u0, cur.v, cur.k.x, s0); VFMA(u1, cur.v, cur.k.y, s1); VFMA(u2, cur.v, cur.k.z, s2); VFMA(u3, cur.v, cur.k.w, s3); \
                  const float sa = rowsum16(p); \
                  VFMA(s0, sa, cur.b.x, u0); VFMA(s1, sa, cur.b.y, u1); VFMA(s2, sa, cur.b.z, u2); VFMA(s3, sa, cur.b.w, u3); \
                  VMUL(QV, s0, cur.r.x); VFMA(QV, s1, cur.r.y, QV); VFMA(QV, s2, cur.r.z, QV); VFMA(QV, s3, cur.r.w, QV); \
                  cur = nx1; nx1 = nxt; } while (0)
#pragma unroll 2
              for (int t0 = 0; t0 < 64; t0 += 4) {
                  float q0, q1, q2, q3;
                  SCAN_STEP(q0, t0); SCAN_STEP(q1, t0 + 1); SCAN_STEP(q2, t0 + 2); SCAN_STEP(q3, t0 + 3);
                  float x01 = hi8 ? q1 : q0; const float y01 = hi8 ? q0 : q1; x01 += dpp_f<0x128>(y01);
                  float x23 = hi8 ? q3 : q2; const float y23 = hi8 ? q2 : q3; x23 += dpp_f<0x128>(y23);
                  float x = hi4 ? x23 : x01; const float yy = hi4 ? x01 : x23; x += dpp_f<0x141>(yy);
                  x += dpp_f<0xB1>(x); x += dpp_f<0x4E>(x);
                  pYq[t0 * 32] = x;
              }
              { const f32x4 gT = *(const LAS f32x4*)(C.lds + L_GT + 16 * jq); s0 *= gT.x; s1 *= gT.y; s2 *= gT.z; s3 *= gT.w; } }
#undef SCAN_STEP
            __syncthreads();
            { const int r4i = (tid & 7) * 4; const f32x4 y4 = *(const LAS f32x4*)(sY + tt * 32 + r4i);
              { u32x2 yw; yw.x = pkbf(y4.x, y4.y); yw.y = pkbf(y4.z, y4.w); *(u32x2*)(C.Yraw + (row0 + ch * 64 + tt) * 1024 + h * 64 + half * 32 + r4i) = yw; }
              if (half == 0 && tid < 64) C.bonus[(row0 + ch * 64 + tid) * 16 + h] = sBON[tid]; }
        }
        *(f32x4*)(C.out + (sample ? O_WKVS : O_WKVP) + ((size_t)(b * 16 + h) * 64 + i) * 64 + 4 * jq) = (f32x4){s0, s1, s2, s3};
        __syncthreads();
    }
#undef SCAN_ISSUE
#undef SCAN_ISSUE_AT
#undef SCAN_LOAD
#undef VMUL
#undef VFMA
}

constexpr int L_KS = 0, L_VT = 27648, L_OW = 53248;
__device__ __forceinline__ void load8(const Ctx& C, bool sample, bool isV, int b, int kvh, size_t qrow0, int key, int kmin, int c8, unsigned (&w)[4]) {
    if (key < kmin) { w[0] = w[1] = w[2] = w[3] = 0u; return; }
    if (sample && key < 128) { const float* src = (isV ? C.cache_v : C.cache_k) + ((size_t)(b * 128 + key) * 4 + kvh) * 64 + c8;
        const f32x4 s0 = *(const f32x4*)src, s1 = *(const f32x4*)(src + 4);
        w[0] = pkbf(s0.x, s0.y); w[1] = pkbf(s0.z, s0.w); w[2] = pkbf(s1.x, s1.y); w[3] = pkbf(s1.z, s1.w); return; }
    const u32x4 v = *(const u32x4*)(C.Z + (qrow0 + key - 128) * ZW + (isV ? ZVB : ZKB) + kvh * 64 + c8);
    w[0] = v.x; w[1] = v.y; w[2] = v.z; w[3] = v.w;
}
__device__ __forceinline__ void attn_item(const Ctx& C, int item) {
    const int tid = C.tid, lane = C.lane, wave = C.wave, fr = lane & 15, fq = lane >> 4;
    const bool sample = item >= 1024; int b, c, kvh;
    if (!sample) { b = item >> 7; c = (item >> 2) & 31; kvh = item & 3; } else { const int s = item - 1024; b = s >> 2; kvh = s & 3; c = 2; }
    const size_t qrow0 = sample ? (size_t)NP_TOK + (size_t)b * 64 : (size_t)b * 2048 + (size_t)c * 64;
    const int kmin = sample ? 0 : (c >= 2 ? 0 : 128 - c * 64);
    LAS bf16_t* Ks = (LAS bf16_t*)(C.lds + L_KS); LAS bf16_t* Vt = (LAS bf16_t*)(C.lds + L_VT);
    for (int p = tid; p < 1536; p += 512) {
        unsigned w[4];
        { const int key = p >> 3, c8 = (p & 7) * 8; load8(C, sample, false, b, kvh, qrow0, key, kmin, c8, w);
          *(LAS u32x4*)(Ks + key * 72 + c8) = (u32x4){w[0], w[1], w[2], w[3]}; }
        { const int key = p % 192, d0 = (p / 192) * 8; load8(C, sample, true, b, kvh, qrow0, key, kmin, d0, w);
#pragma unroll
          for (int e = 0; e < 4; ++e) { Vt[(d0 + 2 * e) * 200 + key] = (bf16_t)(w[e] & 0xffffu); Vt[(d0 + 2 * e + 1) * 200 + key] = (bf16_t)(w[e] >> 16); } }
    }
    __syncthreads();
    const int gq = wave >> 1, qh = wave & 1, hq = kvh * 4 + gq;
    const float slope = exp2f(-0.5f * (float)(hq + 1)), sink = C.sinks[hq];
#pragma unroll 1
    for (int nt = 0; nt < 2; ++nt) {
        bf16x8 qf[2];
#pragma unroll
        for (int ks = 0; ks < 2; ++ks) qf[ks] = *(const bf16x8*)(C.Z + (qrow0 + qh * 32 + nt * 16 + fr) * ZW + ZQ + hq * 64 + ks * 32 + 8 * fq);
        f32x4 sacc[12];
#pragma unroll
        for (int kt = 0; kt < 12; ++kt) sacc[kt] = (f32x4){0.f, 0.f, 0.f, 0.f};
#pragma unroll
        for (int kt = 0; kt < 12; ++kt)
#pragma unroll
            for (int ks = 0; ks < 2; ++ks) { const bf16x8 kf = *(const LAS bf16x8*)(Ks + (16 * kt + fr) * 72 + ks * 32 + 8 * fq);
                sacc[kt] = __builtin_amdgcn_mfma_f32_16x16x32_bf16(kf, qf[ks], sacc[kt], 0, 0, 0); }
        bf16x8 pf[6];
        { const float fd = (float)(qh * 32 + nt * 16 + fr + 128 - 4 * fq); float mx = -1e30f;
#pragma unroll
          for (int kt = 0; kt < 12; ++kt)
#pragma unroll
              for (int j = 0; j < 4; ++j) sacc[kt][j] = __builtin_fmaf(-slope, fabsf(fd - (float)(16 * kt + j)), sacc[kt][j]);
          if (kmin > 0) {
#pragma unroll
              for (int kt = 0; kt < 12; ++kt)
#pragma unroll
                  for (int j = 0; j < 4; ++j) { const int key = 16 * kt + 4 * fq + j; sacc[kt][j] = key >= kmin ? sacc[kt][j] : -1e30f; } }
#pragma unroll
          for (int kt = 0; kt < 12; ++kt)
#pragma unroll
              for (int j = 0; j < 4; ++j) mx = fmaxf(mx, sacc[kt][j]);
          mx = fmaxf(mx, __shfl_xor(mx, 16)); mx = fmaxf(mx, __shfl_xor(mx, 32)); mx = fmaxf(mx, sink);
          float sum = 0.f;
#pragma unroll
          for (int kt = 0; kt < 12; ++kt)
#pragma unroll
              for (int j = 0; j < 4; ++j) { const float e = __expf(sacc[kt][j] - mx); sacc[kt][j] = e; sum += e; }
          sum += __shfl_xor(sum, 16); sum += __shfl_xor(sum, 32);
          const float inv = 1.f / (sum + __expf(sink - mx));
#pragma unroll
          for (int kb = 0; kb < 6; ++kb) { const f32x4 e0 = sacc[2 * kb] * inv, e1 = sacc[2 * kb + 1] * inv;
              const u32x4 w = (u32x4){pkbf(e0[0], e0[1]), pkbf(e0[2], e0[3]), pkbf(e1[0], e1[1]), pkbf(e1[2], e1[3])}; pf[kb] = __builtin_bit_cast(bf16x8, w); }
        }
        f32x4 o[4];
#pragma unroll
        for (int nb = 0; nb < 4; ++nb) o[nb] = (f32x4){0.f, 0.f, 0.f, 0.f};
#pragma unroll
        for (int kb = 0; kb < 6; ++kb)
#pragma unroll
            for (int nb = 0; nb < 4; ++nb) { const LAS bf16_t* vp = Vt + (16 * nb + fr) * 200 + 32 * kb + 4 * fq;
                const u32x2 v0 = *(const LAS u32x2*)vp, v1 = *(const LAS u32x2*)(vp + 16);
                const bf16x8 vf = __builtin_bit_cast(bf16x8, ((u32x4){v0.x, v0.y, v1.x, v1.y}));
                o[nb] = __builtin_amdgcn_mfma_f32_16x16x32_bf16(pf[kb], vf, o[nb], 0, 0, 0); }
        { LAS float* Ow = (LAS float*)(C.lds + L_OW) + wave * (16 * 68);
#pragma unroll
          for (int nb = 0; nb < 4; ++nb)
#pragma unroll
              for (int j = 0; j < 4; ++j) Ow[(4 * fq + j) * 68 + 16 * nb + fr] = o[nb][j];
          const int qq = lane >> 2, dc = (lane & 3) * 16; const size_t tok = qrow0 + qh * 32 + 16 * nt + qq;
          const u32x4 g0 = *(const u32x4*)(C.Z + tok * ZW + ZGB + hq * 64 + dc), g1 = *(const u32x4*)(C.Z + tok * ZW + ZGB + hq * 64 + dc + 8);
          const LAS f32x4* orow = (const LAS f32x4*)(Ow + qq * 68 + dc); const f32x4 o0 = orow[0], o1 = orow[1], o2 = orow[2], o3 = orow[3];
          u32x4 w0, w1;
          w0.x = pkbf(o0.x * bflo(g0.x), o0.y * bfhi(g0.x)); w0.y = pkbf(o0.z * bflo(g0.y), o0.w * bfhi(g0.y)); w0.z = pkbf(o1.x * bflo(g0.z), o1.y * bfhi(g0.z)); w0.w = pkbf(o1.z * bflo(g0.w), o1.w * bfhi(g0.w));
          w1.x = pkbf(o2.x * bflo(g1.x), o2.y * bfhi(g1.x)); w1.y = pkbf(o2.z * bflo(g1.y), o2.w * bfhi(g1.y)); w1.z = pkbf(o3.x * bflo(g1.z), o3.y * bfhi(g1.z)); w1.w = pkbf(o3.z * bflo(g1.w), o3.w * bfhi(g1.w));
          bf16_t* yp = C.Ya + tok * 2048 + 1024 + hq * 64 + dc; *(u32x4*)yp = w0; *(u32x4*)(yp + 8) = w1; }
    }
    __syncthreads();
}
__device__ __forceinline__ void phase3(const Ctx& C) {
    for (int it = C.bid; it < 1152; it += C.G) attn_item(C, it);
    const int gw = C.bid * 8 + C.wave, NGW = C.G * 8, lane = C.lane;
    for (int wi0 = gw; wi0 < MTOK * 16 / 4; wi0 += 4 * NGW) {
        u32x2 yc[4]; f32x4 y4[4]; u32x2 vc[4], vp[4], gc[4]; float bon[4];
#pragma unroll
        for (int u = 0; u < 4; ++u) { const int wi = wi0 + u * NGW; if (wi < MTOK * 16 / 4) {
            const int pr = wi * 4 + (lane >> 4), tok = pr >> 4, h = pr & 15, col = h * 64 + 4 * (lane & 15); const bf16_t* zr = C.Z + (size_t)tok * ZW;
            yc[u] = __builtin_nontemporal_load((const u32x2*)(C.Yraw + (size_t)tok * 1024 + col)); vc[u] = *(const u32x2*)(zr + ZV + col); vp[u] = *(const u32x2*)(zr - (tok > 0 ? ZW : 0) + ZV + col);
            gc[u] = *(const u32x2*)(zr + ZGA + col); bon[u] = C.bonus[(size_t)tok * 16 + h]; } }
#pragma unroll
        for (int u = 0; u < 4; ++u) { const int wi = wi0 + u * NGW; if (wi < MTOK * 16 / 4) {
            const int pr = wi * 4 + (lane >> 4), tok = pr >> 4, h = pr & 15, col = h * 64 + 4 * (lane & 15);
            y4[u] = (f32x4){bflo(yc[u].x), bfhi(yc[u].x), bflo(yc[u].y), bfhi(yc[u].y)};
            const float mean = rowsum16((y4[u].x + y4[u].y) + (y4[u].z + y4[u].w)) * (1.f / 64.f); const f32x4 d = y4[u] - mean;
            const float var = rowsum16((d.x * d.x + d.y * d.y) + (d.z * d.z + d.w * d.w)) * (1.f / 64.f); const float rstd = rsqrtf(var + 64e-5f);
            const f32x4 v = (f32x4){bflo(vc[u].x), bfhi(vc[u].x), bflo(vc[u].y), bfhi(vc[u].y)}; f32x4 pv = (f32x4){bflo(vp[u].x), bfhi(vp[u].x), bflo(vp[u].y), bfhi(vp[u].y)};
            const int tin = tok < NP_TOK ? (tok & 2047) : ((tok - NP_TOK) & 63);
            if (tin == 0) { if (tok >= NP_TOK) pv = *(const f32x4*)(C.state_shift + (size_t)((tok - NP_TOK) >> 6) * SHIFT_W + 2048 + col); else pv = (f32x4){0.f, 0.f, 0.f, 0.f}; }
            const f32x4 mu4 = *(const f32x4*)(C.mu + 2048 + col); const f32x4 vs = v + mu4 * (pv - v);
            const f32x4 g4 = (f32x4){bflo(gc[u].x), bfhi(gc[u].x), bflo(gc[u].y), bfhi(gc[u].y)};
            const f32x4 lw = *(const f32x4*)(C.lnx_w + col), lb = *(const f32x4*)(C.lnx_b + col);
            const f32x4 o = (d * rstd * lw + lb + vs * bon[u]) * g4;
            u32x2 w; w.x = pkbf(o.x, o.y); w.y = pkbf(o.z, o.w); *(u32x2*)(C.Ya + (size_t)tok * 2048 + col) = w; } }
    }
}

__device__ __forceinline__ void phase6(const Ctx& C) {
    const int gw = C.bid * 8 + C.wave, NGW = C.G * 8;
    int m = gw; u32x4 v[4], vn[4];
    if (m >= MTOK) return;
    { const u32x4* xr = (const u32x4*)(C.out + (size_t)m * DM) + C.lane;
#pragma unroll
      for (int j = 0; j < 4; ++j) v[j] = xr[64 * j]; }
    for (;;) { const int mn = m + NGW; const bool more = mn < MTOK;
        if (more) { const u32x4* xn = (const u32x4*)(C.out + (size_t)mn * DM) + C.lane;
#pragma unroll
            for (int j = 0; j < 4; ++j) vn[j] = xn[64 * j]; }
        f32x4 f[4][2]; float s = 0.f;
#pragma unroll
        for (int j = 0; j < 4; ++j) { f[j][0] = (f32x4){bflo(v[j].x), bfhi(v[j].x), bflo(v[j].y), bfhi(v[j].y)}; f[j][1] = (f32x4){bflo(v[j].z), bfhi(v[j].z), bflo(v[j].w), bfhi(v[j].w)};
            s += (f[j][0].x * f[j][0].x + f[j][0].y * f[j][0].y) + (f[j][0].z * f[j][0].z + f[j][0].w * f[j][0].w) + (f[j][1].x * f[j][1].x + f[j][1].y * f[j][1].y) + (f[j][1].z * f[j][1].z + f[j][1].w * f[j][1].w); }
        const float rs = rsqrtf(wave_sum(s) * (1.f / DM) + 1e-6f);
        const f32x4* gr = (const f32x4*)C.g_final + 2 * C.lane; f32x4* orow = (f32x4*)(C.out + (size_t)m * DM) + 2 * C.lane;
#pragma unroll
        for (int j = 0; j < 4; ++j) { orow[128 * j] = f[j][0] * rs * gr[128 * j]; orow[128 * j + 1] = f[j][1] * rs * gr[128 * j + 1]; }
        if (!more) break;
#pragma unroll
        for (int j = 0; j < 4; ++j) v[j] = vn[j];
        m = mn; }
}

#define XB_TMO      128
#define XB_XCNT(j)  (256  + 64 * (j))
#define XB_XSUB(j)  (1280 + 64 * (j))
#define XB_XGEN(j)  (2304 + 64 * (j))
#define XB_TOP      3328
#define XB_TOPGEN   3392
#define XCD_BAR_WORDS 3456
#define XB_SPIN_CAP (1u << 18)

__device__ __forceinline__ unsigned xb_ld(unsigned* p)              { return __hip_atomic_load(p, __ATOMIC_RELAXED, __HIP_MEMORY_SCOPE_AGENT); }
__device__ __forceinline__ unsigned xb_add(unsigned* p, unsigned v) { return __hip_atomic_fetch_add(p, v, __ATOMIC_RELAXED, __HIP_MEMORY_SCOPE_AGENT); }
__device__ __forceinline__ unsigned xb_xcc_id() { return (unsigned)__builtin_amdgcn_s_getreg((3 << 11) | 20) & 0xFu; }
#define XB_SPIN(cond, bar) do { unsigned _sp = 0; while (cond) { __builtin_amdgcn_s_sleep(1); \
    if ((++_sp & 255u) == 0u) { if (xb_ld(&(bar)[XB_TMO])) break; if (_sp > XB_SPIN_CAP) { atomicAdd(&(bar)[XB_TMO], 1u); break; } } } } while (0)

struct XcdBarrier {
    unsigned* bar; unsigned x;
    volatile LAS unsigned* st;
};

__device__ __forceinline__ XcdBarrier xcd_barrier_post(unsigned* bar, volatile LAS unsigned* st) {
    XcdBarrier b; b.bar = bar; b.x = xb_xcc_id(); b.st = st;
    if (threadIdx.x == 0) (void)xb_add(&bar[XB_XCNT(b.x)], 1u);
    return b;
}
__device__ __forceinline__ void xcd_barrier_complete(unsigned* bar, unsigned x, unsigned& nloc, unsigned& nx) {
    const unsigned G = gridDim.x * gridDim.y * gridDim.z;
    unsigned sum, cnt, mine, sp = 0u;
    for (;;) {
        sum = 0u; cnt = 0u; mine = 0u;
#pragma unroll
        for (unsigned j = 0; j < 16; ++j) { const unsigned c = xb_ld(&bar[XB_XCNT(j)]); sum += c; cnt += (c > 0u) ? 1u : 0u; mine = (j == x) ? c : mine; }
        if (sum == G) break;
        __builtin_amdgcn_s_sleep(1);
        if ((++sp & 255u) == 0u) { if (xb_ld(&bar[XB_TMO])) break; if (sp > XB_SPIN_CAP) { atomicAdd(&bar[XB_TMO], 1u); break; } }
    }
    nloc = mine > 0u ? mine : 1u; nx = cnt > 0u ? cnt : 1u;
}

__device__ __forceinline__ void xcd_barrier(const XcdBarrier& b) {
    asm volatile("s_waitcnt vmcnt(0)" ::: "memory");
    __syncthreads();
    if (threadIdx.x == 0) {
        unsigned* bar = b.bar;
        __builtin_amdgcn_s_waitcnt(0);
        unsigned nloc = b.st[0], nx = b.st[1];
        if (nloc == 0u) { xcd_barrier_complete(bar, b.x, nloc, nx); b.st[0] = nloc; b.st[1] = nx; }
        const unsigned old = xb_add(&bar[XB_XSUB(b.x)], 1u);
        const unsigned gen = old / nloc;
        if (old + 1u == (gen + 1u) * nloc) {
            __builtin_amdgcn_fence(__ATOMIC_RELEASE, "agent");
            asm volatile("s_waitcnt vmcnt(0)" ::: "memory");
            const unsigned og = xb_add(&bar[XB_TOP], 1u);
            const unsigned tg = og / nx;
            if (og + 1u == (tg + 1u) * nx) xb_add(&bar[XB_TOPGEN], 1u);
            else XB_SPIN(xb_ld(&bar[XB_TOPGEN]) == tg, bar);
            __builtin_amdgcn_fence(__ATOMIC_ACQUIRE, "agent");
            xb_add(&bar[XB_XGEN(b.x)], 1u);
            asm volatile("s_waitcnt vmcnt(0)" ::: "memory");
        } else {
            XB_SPIN(xb_ld(&bar[XB_XGEN(b.x)]) == gen, bar);
            __builtin_amdgcn_fence(__ATOMIC_ACQUIRE, "agent");
            asm volatile("s_waitcnt vmcnt(0)" ::: "memory");
        }
    }
    __syncthreads();
}

__global__ void __launch_bounds__(512, 2) mega_fwd(Args a) {
    extern __shared__ __attribute__((aligned(16))) unsigned char lds_raw[];
    cg::grid_group grid = cg::this_grid();
    Ctx C;
    C.x_prompt = a.in[0]; C.x_sample = a.in[1]; C.state_wkv = a.in[2]; C.state_shift = a.in[3]; C.cache_k = a.in[4]; C.cache_v = a.in[5]; C.g_norm = a.in[6]; C.w_in = a.in[7];
    C.mu = a.in[8]; C.w0 = a.in[9]; C.w_w_up = a.in[10]; C.a0 = a.in[11]; C.w_a_up = a.in[12]; C.k_k = a.in[13]; C.k_a = a.in[14]; C.r_k = a.in[15]; C.lnx_w = a.in[16]; C.lnx_b = a.in[17];
    C.sinks = a.in[18]; C.p_a = a.in[19]; C.p_b = a.in[20]; C.w_o = a.in[21]; C.g_final = a.in[22];
    C.out = a.out; C.ws = a.ws;
    C.WinT = (bf16_t*)(a.ws + WS_WIN); C.PaT = (bf16_t*)(a.ws + WS_PA); C.PbT = (bf16_t*)(a.ws + WS_PB); C.WoT = (bf16_t*)(a.ws + WS_WO);
    C.WwT = (bf16_t*)(a.ws + WS_WW); C.WaT = (bf16_t*)(a.ws + WS_WA); C.bonus = (float*)(a.ws + WS_BON); C.Z = (bf16_t*)(a.ws + WS_Z);
    C.H = (bf16_t*)((unsigned char*)a.out + DO_H); C.Yraw = (bf16_t*)((unsigned char*)a.out + DO_YRAW); C.Ya = (bf16_t*)((unsigned char*)a.out + DO_YA); C.Yb = (bf16_t*)((unsigned char*)a.out + DO_YB);
    C.lds = (LAS unsigned char*)lds_raw;
    C.tid = threadIdx.x; C.lane = C.tid & 63; C.wave = __builtin_amdgcn_readfirstlane(C.tid >> 6); C.G = gridDim.x; C.bid = blockIdx.x;
    const int lo = a.ph_lo, hi = a.ph_hi;
    volatile LAS unsigned* misc = (volatile LAS unsigned*)(C.lds + L_MISC);
    if (C.tid < 2) misc[C.tid] = 0u;
    __syncthreads();
    XcdBarrier bar; bar.bar = (unsigned*)(a.ws + WS_BAR); bar.x = 0; bar.st = nullptr;
    if (hi - lo > 1) bar = xcd_barrier_post((unsigned*)(a.ws + WS_BAR), misc);
    if (lo > hi) grid.sync();
#define IN(k) (lo <= (k) && (k) < hi)
#define SEAM(k) do { if (IN(k) && IN((k) + 1)) xcd_barrier(bar); } while (0)
    if (IN(0)) phase0(C);
    SEAM(0);
    if (IN(1)) { pg8::Gemm g{C.H, C.WinT, MTOK, ZW, DM, DM}; pg8::StaticOrder S; S.init(MTOK, ZW, C.G, C.bid); EpiZ E{C.Z};
        pg8::gemm_phase<EpiZ, pg8::StaticOrder, true, true>(C.lds, g, S, E);
        { const int first = (72 * 43) % C.G, nidle = C.G - first; if (C.bid >= first) tr_run(C, (LAS float*)(C.lds + C.wave * 16384), (C.bid - first) * 8 + C.wave, nidle * 8, 1); } }
    SEAM(1);
    if (IN(2)) scan_phase(C);
    SEAM(2);
    if (IN(3)) phase3(C);
    SEAM(3);
    if (IN(4)) {
        { pg8::Gemm g{C.Ya, C.PaT, MTOK, DM, 2048, 2048}; pg8::StaticOrder S; S.init(MTOK, DM, C.G, C.bid); EpiMergeK E{C.Z};
          pg8::gemm_phase<EpiMergeK, pg8::StaticOrder, true, true>(C.lds, g, S, E); }
    }
    SEAM(4);
    if (IN(5)) { pg8::Gemm g{C.Z + ZMB, C.WoT, MTOK, DM, DM, ZW}; pg8::StaticOrder S; S.init(MTOK, DM, C.G, C.bid); EpiOut E{C.x_prompt, C.x_sample, C.out};
        pg8::gemm_phase<EpiOut, pg8::StaticOrder, true, true>(C.lds, g, S, E); }
    SEAM(5);
    if (IN(6)) phase6(C);
#undef IN
#undef SEAM
}

extern "C" void kernel_launch(void* const* d_in, const int* in_sizes, int n_in, void* d_out, int out_size, void* d_ws, size_t ws_size, hipStream_t stream) {
    static int grid = 0;
    if (grid == 0) {
        if (n_in != 23 || (size_t)out_size != O_END || ws_size < WS_END) { fprintf(stderr, "kernel_launch: unexpected sizes: n_in %d out %d ws %zu (need %zu)\n", n_in, out_size, ws_size, (size_t)WS_END); grid = -1; return; }
        int dev = 0, cus = 0, per_cu = 0;
        if (hipGetDevice(&dev) != hipSuccess || hipDeviceGetAttribute(&cus, hipDeviceAttributeMultiprocessorCount, dev) != hipSuccess) { grid = -1; return; }
        if (hipFuncSetAttribute((const void*)mega_fwd, hipFuncAttributeMaxDynamicSharedMemorySize, LDS_BYTES) != hipSuccess) { fprintf(stderr, "kernel_launch: hipFuncSetAttribute failed\n"); grid = -1; return; }
        if (hipOccupancyMaxActiveBlocksPerMultiprocessor(&per_cu, (const void*)mega_fwd, 512, LDS_BYTES) != hipSuccess || per_cu < 1) { fprintf(stderr, "kernel_launch: occupancy query failed (%d)\n", per_cu); (void)hipGetLastError(); grid = -1; return; }
        grid = cus * per_cu;
        fprintf(stderr, "kernel_launch: %d CUs x %d = grid %d\n", cus, per_cu, grid);
    }
    if (grid < 0) return;
    if (hipMemsetAsync((char*)d_ws + WS_BAR, 0, BAR_BYTES, stream) != hipSuccess) { fprintf(stderr, "kernel_launch: hipMemsetAsync failed\n"); return; }
    Args a{};
    for (int i = 0; i < 23; ++i) a.in[i] = (const float*)d_in[i];
    a.out = (float*)d_out; a.ws = (unsigned char*)d_ws;
#if MK_MULTI
    for (int k = 0; k < NPHASE; ++k) { a.ph_lo = k; a.ph_hi = k + 1; hipLaunchKernelGGL(mega_fwd, dim3(grid), dim3(512), LDS_BYTES, stream, a); }
#else
    a.ph_lo = 0; a.ph_hi = NPHASE;
    void* args[] = {&a};
    const hipError_t e = hipLaunchCooperativeKernel((const void*)mega_fwd, dim3(grid), dim3(512), args, LDS_BYTES, stream);
    if (e != hipSuccess) fprintf(stderr, "kernel_launch: cooperative launch failed: %s (grid %d)\n", hipGetErrorString(e), grid);
#endif
}
```

```cpp
#include <hip/hip_runtime.h>
#include <hip/hip_cooperative_groups.h>
#include <cstdio>
#include <cstdint>
namespace cg = cooperative_groups;

#ifndef MK_MULTI
#define MK_MULTI 0
#endif

namespace pg8 {
#define PG8_LAS __attribute__((address_space(3)))
typedef unsigned short bf16_t;
typedef short bf16x8 __attribute__((ext_vector_type(8)));
typedef float f32x4 __attribute__((ext_vector_type(4)));
typedef unsigned u32x4 __attribute__((ext_vector_type(4)));
constexpr int BM = 256, BK = 64, HALF = 128, HTB = HALF * BK * 2, STAGE_BYTES = 8 * HTB, NXCD = 8, WGM = 8;
__host__ __device__ __forceinline__ int lds_byte(int r, int c) { const int st = (r >> 4) * 2 + (c >> 5), rr = r & 15, cc = c & 31, ob = rr * 64 + cc * 2; return st * 1024 + (ob ^ (((ob >> 9) & 1) << 5)); }
__host__ __device__ __forceinline__ void stage_rc(int b, int& R, int& C) { const int st = b / 1024, sb = b % 1024, swz = sb ^ (((sb >> 9) & 1) << 5); R = (st >> 1) * 16 + swz / 64; C = (st & 1) * 32 + (swz % 64) / 2; }
__host__ __device__ __forceinline__ int perm32(int rho) { const int n = rho >> 4, i = rho & 15; return 8 * (i >> 2) + 4 * n + (i & 3); }
struct Unit { int pm, pn; };
struct Gemm { const bf16_t* A; const bf16_t* Bt; int M, N, K, lda; };
struct StaticOrder {
    int nM, nN, nwg, G, c;
    __host__ __device__ void init(int M, int N, int G_, int c_) { nM = M / BM; nN = N / BM; nwg = nM * nN; G = G_; c = c_; }
    __host__ __device__ bool next(int i, Unit& u) const {
        const long L = (long)i * G + c; if (L >= nwg) return false;
        int wgid = (int)L; { const int q = nwg / NXCD, r = nwg % NXCD, xcd = wgid % NXCD, off = wgid / NXCD; wgid = (xcd < r ? xcd * (q + 1) : r * (q + 1) + (xcd - r) * q) + off; }
        const int nig = WGM * nN, gid = wgid / nig, fm = gid * WGM, gsz = (nM - fm) < WGM ? (nM - fm) : WGM;
        u.pm = fm + ((wgid % nig) % gsz); u.pn = (wgid % nig) / gsz; return true;
    }
    __device__ __forceinline__ void a_ready(const Unit&) const {}
    __device__ __forceinline__ void done(const Unit&) const {}
};
__device__ __forceinline__ unsigned cvt_pk_bf16(float lo, float hi) { unsigned r; asm volatile("v_cvt_pk_bf16_f32 %0, %1, %2" : "=v"(r) : "v"(lo), "v"(hi)); return r; }
template <class Epi, class Sched, bool ALIGN_EPI = false, bool SP2 = false>
__device__ __forceinline__ void gemm_phase(PG8_LAS unsigned char* lds, const Gemm g, const Sched& S, const Epi& E) {
    const int tid = threadIdx.x, wid = __builtin_amdgcn_readfirstlane(tid >> 6), lane = tid & 63, wr = wid >> 2, wc = wid & 3, fr = lane & 15, fq = lane >> 4;
    const int K = g.K, nt = K / BK;
    unsigned voffA[2], voffB[2];
#pragma unroll
    for (int i = 0; i < 2; ++i) { int R, C; stage_rc(tid * 16 + i * 8192, R, C); const int Rb = Epi::PERM ? ((R & ~31) + perm32(R & 31)) : R;
        voffA[i] = (unsigned)(R * g.lda + C) * 2u; voffB[i] = (unsigned)(Rb * K + C) * 2u; }
    const size_t kstep = (size_t)(BK * 2);
    const size_t hstepB = (size_t)HALF * K * 2, hstepA = (size_t)HALF * g.lda * 2;
    const size_t tstepB = 2 * hstepB, tstepA = 2 * hstepA;
    const unsigned ldsw = (unsigned)wid * 1024u;
    const int aoff = lds_byte(wr * 64 + fr, fq * 8), boff = lds_byte(wc * 32 + fr, fq * 8);
#define PG8_SA(b, h) (((b) * 2 + (h)) * HTB)
#define PG8_SB(b, h) ((4 + (b) * 2 + (h)) * HTB)
#define PG8_STAGE(bufoff, gbase, voff) do { _Pragma("unroll") for (int _i = 0; _i < 2; ++_i) \
        __builtin_amdgcn_global_load_lds((const unsigned*)((const char*)(gbase) + (voff)[_i]), (PG8_LAS unsigned*)(lds + (bufoff) + ldsw + _i * 8192), 16, 0, 0); } while (0)
#define PG8_LDA(dst, b, h) do { _Pragma("unroll") for (int m = 0; m < 4; ++m) _Pragma("unroll") for (int k = 0; k < 2; ++k) dst[m][k] = *(const PG8_LAS bf16x8*)(lds + PG8_SA(b, h) + aoff + m * 2048 + k * 1024); } while (0)
#define PG8_LDB(dst, b, h) do { _Pragma("unroll") for (int n = 0; n < 2; ++n) _Pragma("unroll") for (int k = 0; k < 2; ++k) dst[n][k] = *(const PG8_LAS bf16x8*)(lds + PG8_SB(b, h) + boff + n * 2048 + k * 1024); } while (0)
#define PG8_MMA(ai, bj, At, Bt) do { __builtin_amdgcn_s_setprio(1); _Pragma("unroll") for (int m = 0; m < 4; ++m) _Pragma("unroll") for (int n = 0; n < 2; ++n) _Pragma("unroll") for (int k = 0; k < 2; ++k) \
        acc[ai][bj][m][n] = __builtin_amdgcn_mfma_f32_16x16x32_bf16(Bt[n][k], At[m][k], acc[ai][bj][m][n], 0, 0, 0); __builtin_amdgcn_s_setprio(0); } while (0)
#define PG8_WAIT_V(n) asm volatile("s_waitcnt vmcnt(" #n ")" ::: "memory")
#define PG8_WAIT_L(n) asm volatile("s_waitcnt lgkmcnt(" #n ")" ::: "memory")
#define PG8_BAR __builtin_amdgcn_s_barrier()
#define PG8_SCHED __builtin_amdgcn_sched_barrier(0)
    Unit cur, nxt; int ui = 0;
    if (!S.next(0, cur)) return;
    f32x4 acc[2][2][4][2];
#pragma unroll
    for (int a = 0; a < 2; ++a)
#pragma unroll
        for (int b = 0; b < 2; ++b)
#pragma unroll
            for (int m = 0; m < 4; ++m)
#pragma unroll
                for (int n = 0; n < 2; ++n) acc[a][b][m][n] = (f32x4){0.f, 0.f, 0.f, 0.f};
    bf16x8 At[4][2], B0[2][2], B1[2][2];
    const char* cA = (const char*)g.A + (size_t)cur.pm * tstepA; const char* cB = (const char*)g.Bt + (size_t)cur.pn * tstepB;
    S.a_ready(cur);
    if constexpr (SP2) {
        PG8_STAGE(PG8_SB(0, 0), cB, voffB); PG8_STAGE(PG8_SB(0, 1), cB + hstepB, voffB); PG8_STAGE(PG8_SA(0, 0), cA, voffA); PG8_STAGE(PG8_SA(0, 1), cA + hstepA, voffA);
        if (wr == 1) PG8_BAR;
        PG8_WAIT_V(2); PG8_BAR;
        PG8_STAGE(PG8_SB(1, 0), cB + kstep, voffB); PG8_STAGE(PG8_SA(1, 0), cA + kstep, voffA); PG8_STAGE(PG8_SB(1, 1), cB + hstepB + kstep, voffB);
        PG8_WAIT_V(6); PG8_BAR;
    } else {
        PG8_STAGE(PG8_SB(0, 0), cB, voffB); PG8_STAGE(PG8_SA(0, 0), cA, voffA); PG8_STAGE(PG8_SB(0, 1), cB + hstepB, voffB); PG8_STAGE(PG8_SA(0, 1), cA + hstepA, voffA);
        if (wr == 1) PG8_BAR;
        PG8_WAIT_V(4); PG8_BAR;
        PG8_STAGE(PG8_SB(1, 0), cB + kstep, voffB); PG8_STAGE(PG8_SA(1, 0), cA + kstep, voffA); PG8_STAGE(PG8_SB(1, 1), cB + hstepB + kstep, voffB);
        PG8_WAIT_V(6); PG8_BAR;
    }
    for (;;) {
        const bool has_next = S.next(ui + 1, nxt);
        const char* nA = has_next ? (const char*)g.A + (size_t)nxt.pm * tstepA : cA; const char* nB = has_next ? (const char*)g.Bt + (size_t)nxt.pn * tstepB : cB;
        for (int t = 0; t < nt; t += 2) {
            const bool last = (t == nt - 2);
            if constexpr (Epi::MIDHOOK) { if (t == nt / 2) { asm volatile("" ::: "memory"); __builtin_amdgcn_sched_barrier(0); E.mid(acc, cur, wr, wc, fr, fq); asm volatile("" ::: "memory"); __builtin_amdgcn_sched_barrier(0); } }
            const char* a1 = cA + (size_t)(t + 1) * kstep;
            const char* a2 = last ? nA : cA + (size_t)(t + 2) * kstep; const char* b2 = last ? nB : cB + (size_t)(t + 2) * kstep;
            const char* a3 = a2 + kstep; const char* b3 = b2 + kstep;
            if (last && has_next) S.a_ready(nxt);
            if constexpr (SP2) {
            PG8_LDB(B0, 0, 0); PG8_LDB(B1, 0, 1); PG8_SCHED; PG8_LDA(At, 0, 0); PG8_STAGE(PG8_SA(1, 1), a1 + hstepA, voffA);
            PG8_WAIT_V(8); PG8_WAIT_L(0); PG8_BAR; PG8_MMA(0, 0, At, B0); PG8_MMA(0, 1, At, B1); PG8_BAR; PG8_SCHED;
            PG8_LDA(At, 0, 1); PG8_STAGE(PG8_SB(0, 0), b2, voffB); PG8_STAGE(PG8_SB(0, 1), b2 + hstepB, voffB); PG8_STAGE(PG8_SA(0, 0), a2, voffA);
            PG8_WAIT_V(8); PG8_WAIT_L(0); PG8_BAR; PG8_MMA(1, 0, At, B0); PG8_MMA(1, 1, At, B1); PG8_BAR; PG8_SCHED;
            PG8_LDB(B0, 1, 0); PG8_LDB(B1, 1, 1); PG8_SCHED; PG8_LDA(At, 1, 0); PG8_STAGE(PG8_SA(0, 1), a2 + hstepA, voffA);
            PG8_WAIT_V(8); PG8_WAIT_L(0); PG8_BAR; PG8_MMA(0, 0, At, B0); PG8_MMA(0, 1, At, B1); PG8_BAR; PG8_SCHED;
            PG8_LDA(At, 1, 1); PG8_STAGE(PG8_SB(1, 0), b3, voffB); PG8_STAGE(PG8_SB(1, 1), b3 + hstepB, voffB); PG8_STAGE(PG8_SA(1, 0), a3, voffA);
            PG8_WAIT_V(8); PG8_WAIT_L(0); PG8_BAR; PG8_MMA(1, 0, At, B0); PG8_MMA(1, 1, At, B1); PG8_BAR; PG8_SCHED;
            } else {
            PG8_LDB(B0, 0, 0); PG8_SCHED; PG8_LDA(At, 0, 0); PG8_STAGE(PG8_SA(1, 1), a1 + hstepA, voffA);
            PG8_WAIT_L(8); PG8_BAR; PG8_WAIT_L(0); PG8_MMA(0, 0, At, B0); PG8_BAR; PG8_SCHED;
            PG8_LDB(B1, 0, 1); PG8_STAGE(PG8_SB(0, 0), b2, voffB);
            PG8_BAR; PG8_WAIT_L(0); PG8_MMA(0, 1, At, B1); PG8_BAR;
            PG8_LDA(At, 0, 1); PG8_STAGE(PG8_SA(0, 0), a2, voffA);
            PG8_BAR; PG8_WAIT_L(0); PG8_MMA(1, 0, At, B0); PG8_BAR; PG8_SCHED;
            PG8_STAGE(PG8_SB(0, 1), b2 + hstepB, voffB);
            PG8_WAIT_V(6); PG8_BAR; PG8_MMA(1, 1, At, B1); PG8_BAR;
            PG8_LDB(B0, 1, 0); PG8_SCHED; PG8_LDA(At, 1, 0); PG8_STAGE(PG8_SA(0, 1), a2 + hstepA, voffA);
            PG8_WAIT_L(8); PG8_BAR; PG8_WAIT_L(0); PG8_MMA(0, 0, At, B0); PG8_BAR; PG8_SCHED;
            PG8_LDB(B1, 1, 1); PG8_STAGE(PG8_SB(1, 0), b3, voffB);
            PG8_BAR; PG8_WAIT_L(0); PG8_MMA(0, 1, At, B1); PG8_BAR;
            PG8_LDA(At, 1, 1); PG8_STAGE(PG8_SA(1, 0), a3, voffA);
            PG8_BAR; PG8_WAIT_L(0); PG8_MMA(1, 0, At, B0); PG8_BAR; PG8_SCHED;
            PG8_STAGE(PG8_SB(1, 1), b3 + hstepB, voffB);
            PG8_WAIT_V(6); PG8_BAR; PG8_MMA(1, 1, At, B1); PG8_BAR;
            }
        }
        if constexpr (ALIGN_EPI) { if (wr == 0) PG8_BAR; }
        if constexpr (!Epi::AFTER_DRAIN) { E(acc, cur, wr, wc, fr, fq); S.done(cur); }
        if (!has_next) break;
#pragma unroll
        for (int a = 0; a < 2; ++a)
#pragma unroll
            for (int b = 0; b < 2; ++b)
#pragma unroll
                for (int m = 0; m < 4; ++m)
#pragma unroll
                    for (int n = 0; n < 2; ++n) acc[a][b][m][n] = (f32x4){0.f, 0.f, 0.f, 0.f};
        cur = nxt; cA = nA; cB = nB; ++ui;
        if constexpr (ALIGN_EPI) { if (wr == 1) PG8_BAR; }
    }
    PG8_WAIT_V(0);
    if constexpr (!ALIGN_EPI) { if (wr == 0) PG8_BAR; }
    PG8_BAR;
    if constexpr (Epi::AFTER_DRAIN) { E.fused(acc, cur, wr, wc, fr, fq, lds, wid, lane); S.done(cur); }
#undef PG8_SA
#undef PG8_SB
#undef PG8_STAGE
#undef PG8_LDA
#undef PG8_LDB
#undef PG8_MMA
#undef PG8_WAIT_V
#undef PG8_WAIT_L
#undef PG8_BAR
#undef PG8_SCHED
}
}

#define LAS __attribute__((address_space(3)))
typedef unsigned short bf16_t;
typedef short bf16x8 __attribute__((ext_vector_type(8)));
typedef float f32x4 __attribute__((ext_vector_type(4)));
typedef float f32x2 __attribute__((ext_vector_type(2)));
typedef unsigned u32x4 __attribute__((ext_vector_type(4)));
typedef unsigned u32x2 __attribute__((ext_vector_type(2)));

constexpr int DM = 2048, NP_TOK = 16384, MTOK = 18432, SHIFT_W = 3200;
constexpr int ZW = 11008;
constexpr int ZR = 0, ZK = 1024, ZV = 2048, ZGA = 3072, ZQ = 4096, ZKB = 5120, ZVB = 5376, ZGB = 5632, ZMA = 6656, ZMB = 8704, ZWD = 10752, ZAD = 10816;
constexpr size_t MiB = 1u << 20;
constexpr size_t WS_WIN = 0, WS_PA = 43 * MiB, WS_PB = 47 * MiB, WS_WO = 51 * MiB, WS_WW = 59 * MiB, WS_WA = 59 * MiB + 131072, WS_BON = 60 * MiB, WS_Z = 64 * MiB;
constexpr size_t WS_END = WS_Z + (size_t)MTOK * ZW * 2;
constexpr size_t WS_BAR = 63 * MiB, BAR_BYTES = 16384;
constexpr int L_MISC = 147200;
constexpr size_t DO_H = 0, DO_YRAW = 0, DO_YA = 72 * MiB, DO_YB = 108 * MiB;
constexpr size_t O_WKVP = 37748736, O_SHP = O_WKVP + 524288, O_KP = O_SHP + 25600, O_VP = O_KP + 262144, O_WKVS = O_VP + 262144, O_SHS = O_WKVS + 2097152, O_KS = O_SHS + 102400, O_VS = O_KS + 1048576, O_END = O_VS + 1048576;
constexpr int LDS_BYTES = 147456;
constexpr int NPHASE = 7;

struct Args { const float* in[23]; float* out; unsigned char* ws; int ph_lo, ph_hi; };

struct Ctx {
    const float *x_prompt, *x_sample, *state_wkv, *state_shift, *cache_k, *cache_v, *g_norm, *w_in, *mu, *w0, *w_w_up, *a0, *w_a_up, *k_k, *k_a, *r_k, *lnx_w, *lnx_b, *sinks, *p_a, *p_b, *w_o, *g_final;
    float* out; unsigned char* ws;
    bf16_t *WinT, *PaT, *PbT, *WoT, *WwT, *WaT, *Z, *H, *Ya, *Yb, *Yraw; float *bonus;
    LAS unsigned char* lds;
    int tid, lane, wave, G, bid;
};

__device__ __forceinline__ float bflo(unsigned u) { return __uint_as_float(u << 16); }
__device__ __forceinline__ float bfhi(unsigned u) { return __uint_as_float(u & 0xffff0000u); }
__device__ __forceinline__ float bf2f(bf16_t b) { return __uint_as_float((unsigned)b << 16); }
__device__ __forceinline__ unsigned pkbf(float lo, float hi) { return pg8::cvt_pk_bf16(lo, hi); }
__device__ __forceinline__ float wave_sum(float v) {
#pragma unroll
    for (int o = 1; o < 64; o <<= 1) v += __shfl_xor(v, o);
    return v;
}
template <int CTRL> __device__ __forceinline__ float dpp_f(float v) { return __builtin_bit_cast(float, __builtin_amdgcn_update_dpp(0, __builtin_bit_cast(int, v), CTRL, 0xF, 0xF, true)); }
__device__ __forceinline__ float rowsum16(float v) {
    v += dpp_f<0xB1>(v);
    v += dpp_f<0x4E>(v);
    v += dpp_f<0x141>(v);
    v += dpp_f<0x140>(v);
    return v;
}
__device__ __forceinline__ float fast_sigmoid(float x) { return __builtin_amdgcn_rcpf(1.f + __expf(-x)); }
__device__ __forceinline__ float fast_silu(float x) { return x * fast_sigmoid(x); }
__device__ __forceinline__ float fast_tanh(float x) { return 1.f - 2.f * __builtin_amdgcn_rcpf(1.f + __expf(2.f * x)); }
__device__ __forceinline__ const float* xrow(const Ctx& C, int m) { return m < NP_TOK ? C.x_prompt + (size_t)m * DM : C.x_sample + (size_t)(m - NP_TOK) * DM; }
#define LDS_WAIT() asm volatile("s_waitcnt lgkmcnt(0)" ::: "memory")

struct TrItem { const float* src; bf16_t* dst; int N, K; bool zero; };
__device__ __forceinline__ TrItem tr_item(const Ctx& C, int it) {
    constexpr int I_IN = 32 * 344, I_P = 16 * 64, I_O = 32 * 64, I_L = 32;
    TrItem t; int r = it; t.zero = false;
    if (r < I_IN) { const int kb = r / 344, nb = r % 344, zc = 32 * nb; const int src = zc < 3072 ? zc : (zc < 10752 ? zc + 128 : (zc < 10880 ? zc - 10752 + 3072 : -1));
        t.N = 10880; t.K = 2048; t.zero = src < 0; t.src = C.w_in + (size_t)(64 * kb) * 10880 + (src < 0 ? 0 : src); t.dst = C.WinT + (size_t)zc * 2048 + 64 * kb; return t; } r -= I_IN;
    if (r < I_P) { t.N = 2048; t.K = 2048; t.src = C.p_a + (size_t)(64 * (r / 64)) * 2048 + 32 * (r % 64); t.dst = C.PaT + (size_t)(32 * (r % 64)) * 2048 + 64 * (r / 64); return t; } r -= I_P;
    if (r < I_P) { t.N = 2048; t.K = 2048; t.src = C.p_b + (size_t)(64 * (r / 64)) * 2048 + 32 * (r % 64); t.dst = C.PaT + (size_t)(32 * (r % 64)) * 2048 + 1024 + 64 * (r / 64); return t; } r -= I_P;
    if (r < I_O) { t.N = 2048; t.K = 2048; t.src = C.w_o + (size_t)(64 * (r / 64)) * 2048 + 32 * (r % 64); t.dst = C.WoT + (size_t)(32 * (r % 64)) * 2048 + 64 * (r / 64); return t; } r -= I_O;
    if (r < I_L) { t.N = 1024; t.K = 64; t.src = C.w_w_up + 32 * r; t.dst = C.WwT + (size_t)(32 * r) * 64; return t; } r -= I_L;
    t.N = 1024; t.K = 64; t.src = C.w_a_up + 32 * r; t.dst = C.WaT + (size_t)(32 * r) * 64; return t;
}
__device__ __forceinline__ void tr_load(const TrItem& t, int lane, float (&v)[32]) {
#pragma unroll
    for (int i = 0; i < 32; ++i) v[i] = t.zero ? 0.f : __builtin_nontemporal_load(t.src + (size_t)(2 * i + (lane >> 5)) * t.N + (lane & 31));
}
__device__ __forceinline__ void tr_store(const TrItem& t, int lane, const float (&v)[32], LAS float* scr) {
#pragma unroll
    for (int i = 0; i < 32; ++i) scr[(2 * i + (lane >> 5)) * 33 + (lane & 31)] = v[i];
    LDS_WAIT(); asm volatile("" ::: "memory");
    const int c = lane & 7;
#pragma unroll
    for (int j = 0; j < 4; ++j) { const int n = (lane >> 3) + 8 * j; const LAS float* s = scr + (8 * c) * 33 + n;
        u32x4 o; o.x = pkbf(s[0 * 33], s[1 * 33]); o.y = pkbf(s[2 * 33], s[3 * 33]); o.z = pkbf(s[4 * 33], s[5 * 33]); o.w = pkbf(s[6 * 33], s[7 * 33]);
        *(u32x4*)(t.dst + (size_t)n * t.K + 8 * c) = o; }
    LDS_WAIT(); asm volatile("" ::: "memory");
}
__device__ __forceinline__ void tr_run(const Ctx& C, LAS float* scr, int w0, int nw, int set) {
    constexpr int I_IN = 32 * 344, I_MID = 2 * 16 * 64 + 32 * 64, I_L = 2 * 32;
    const int n = set == 0 ? I_IN + I_L : I_MID;
    float va[32], vb[32]; int it = w0;
    if (it >= n) return;
#define TR_ID(i) (set == 0 ? ((i) < I_IN ? (i) : (i) + I_MID) : (i) + I_IN)
    TrItem ta = tr_item(C, TR_ID(it)); tr_load(ta, C.lane, va);
    for (;;) { const int itn = it + nw; const bool more = itn < n; TrItem tb = ta;
        if (more) { tb = tr_item(C, TR_ID(itn)); tr_load(tb, C.lane, vb); }
        tr_store(ta, C.lane, va, scr);
        if (!more) break;
#pragma unroll
        for (int i = 0; i < 32; ++i) va[i] = vb[i];
        ta = tb; it = itn; }
#undef TR_ID
}
__device__ __forceinline__ void phase0(const Ctx& C) {
    LAS float* scr = (LAS float*)(C.lds + C.wave * 16384);
    const int gw = C.bid * 8 + C.wave, NGW = C.G * 8;
    tr_run(C, scr, gw, NGW, 0);
    {
      int m = gw; f32x4 v[8], vn[8];
      if (m < MTOK) { const f32x4* xr = (const f32x4*)xrow(C, m) + C.lane;
#pragma unroll
          for (int j = 0; j < 8; ++j) v[j] = __builtin_nontemporal_load(xr + 64 * j);
          for (;;) { const int mn = m + NGW; const bool more = mn < MTOK;
              if (more) { const f32x4* xn = (const f32x4*)xrow(C, mn) + C.lane;
#pragma unroll
                  for (int j = 0; j < 8; ++j) vn[j] = __builtin_nontemporal_load(xn + 64 * j); }
              float s = 0.f;
#pragma unroll
              for (int j = 0; j < 8; ++j) s += (v[j].x * v[j].x + v[j].y * v[j].y) + (v[j].z * v[j].z + v[j].w * v[j].w);
              const float rs = rsqrtf(wave_sum(s) * (1.f / DM) + 1e-6f);
              u32x2* o8 = (u32x2*)(C.H + (size_t)m * DM) + C.lane; const f32x4* gr = (const f32x4*)C.g_norm + C.lane;
#pragma unroll
              for (int j = 0; j < 8; ++j) { const f32x4 g = gr[64 * j]; u32x2 w; w.x = pkbf(v[j].x * rs * g.x, v[j].y * rs * g.y); w.y = pkbf(v[j].z * rs * g.z, v[j].w * rs * g.w); o8[64 * j] = w; }
              if (!more) break;
#pragma unroll
              for (int j = 0; j < 8; ++j) v[j] = vn[j];
              m = mn; } } }
}

struct EpiZ {
    static constexpr bool PERM = true, AFTER_DRAIN = false, MIDHOOK = false;
    bf16_t* Z;
    __device__ __forceinline__ void operator()(const f32x4 (&acc)[2][2][4][2], const pg8::Unit& u, int wr, int wc, int fr, int fq) const {
        const int pn = u.pn; const int act = (pn >= 12 && pn < 16) || (pn >= 22 && pn < 26) ? 1 : ((pn >= 26 && pn < 42) ? 2 : ((pn >= 16 && pn < 20) ? 3 : 0));
        const int row0 = u.pm * 256 + wr * 64 + fr, col0 = pn * 256 + wc * 32 + 8 * fq;
#pragma unroll
        for (int ai = 0; ai < 2; ++ai)
#pragma unroll
            for (int m = 0; m < 4; ++m) { bf16_t* rowp = Z + (size_t)(row0 + ai * 128 + m * 16) * ZW + col0;
#pragma unroll
                for (int bj = 0; bj < 2; ++bj) { f32x4 v0 = acc[ai][bj][m][0], v1 = acc[ai][bj][m][1];
                    if (act == 1) {
#pragma unroll
                        for (int e = 0; e < 4; ++e) { v0[e] = fast_silu(v0[e]); v1[e] = fast_silu(v1[e]); } }
                    else if (act == 2) {
#pragma unroll
                        for (int e = 0; e < 4; ++e) { v0[e] = fast_sigmoid(v0[e]); v1[e] = fast_sigmoid(v1[e]); } }
                    else if (act == 3) { v0 = v0 * 0.125f; v1 = v1 * 0.125f; }
                    if (act == 2) {
                        unsigned lo = 0u, hi = 0u;
                        lo = __builtin_amdgcn_cvt_pk_u8_f32(__builtin_rintf(v0[0] * 255.f), 0, lo); lo = __builtin_amdgcn_cvt_pk_u8_f32(__builtin_rintf(v0[1] * 255.f), 1, lo); lo = __builtin_amdgcn_cvt_pk_u8_f32(__builtin_rintf(v0[2] * 255.f), 2, lo); lo = __builtin_amdgcn_cvt_pk_u8_f32(__builtin_rintf(v0[3] * 255.f), 3, lo);
                        hi = __builtin_amdgcn_cvt_pk_u8_f32(__builtin_rintf(v1[0] * 255.f), 0, hi); hi = __builtin_amdgcn_cvt_pk_u8_f32(__builtin_rintf(v1[1] * 255.f), 1, hi); hi = __builtin_amdgcn_cvt_pk_u8_f32(__builtin_rintf(v1[2] * 255.f), 2, hi); hi = __builtin_amdgcn_cvt_pk_u8_f32(__builtin_rintf(v1[3] * 255.f), 3, hi);
                        unsigned char* gb = (unsigned char*)(Z + (size_t)(row0 + ai * 128 + m * 16) * ZW + ZMA) + (pn >= 34 ? 2048 + (pn - 34) * 256 : (pn - 26) * 256) + wc * 32 + 8 * fq + bj * 128;
                        *(u32x2*)gb = (u32x2){lo, hi};
                    } else {
                    u32x4 w; w.x = pkbf(v0[0], v0[1]); w.y = pkbf(v0[2], v0[3]); w.z = pkbf(v1[0], v1[1]); w.w = pkbf(v1[2], v1[3]);
                    *(u32x4*)(rowp + bj * 128) = w; } } }
    }
};
template <int PASS> struct EpiMerge {
    static constexpr bool PERM = true, AFTER_DRAIN = false, MIDHOOK = false;
    bf16_t* Z;
    __device__ __forceinline__ void operator()(const f32x4 (&acc)[2][2][4][2], const pg8::Unit& u, int wr, int wc, int fr, int fq) const {
        const int row0 = u.pm * 256 + wr * 64 + fr, col0 = u.pn * 256 + wc * 32 + 8 * fq;
#pragma unroll
        for (int ai = 0; ai < 2; ++ai)
#pragma unroll
            for (int m = 0; m < 4; ++m) { bf16_t* rowz = Z + (size_t)(row0 + ai * 128 + m * 16) * ZW; const unsigned char* gb = (const unsigned char*)(rowz + ZMA) + (PASS ? 2048 : 0) + col0; bf16_t* rowp = rowz + ZMB + col0;
#pragma unroll
                for (int bj = 0; bj < 2; ++bj) { const f32x4 v0 = acc[ai][bj][m][0], v1 = acc[ai][bj][m][1];
                    const u32x2 g8 = __builtin_nontemporal_load((const u32x2*)(gb + bj * 128)); const float k = 1.f / 255.f; float r[8];
                    const float g0 = (float)((g8.x >> 0) & 0xffu) * k, g1 = (float)((g8.x >> 8) & 0xffu) * k, g2 = (float)((g8.x >> 16) & 0xffu) * k, g3 = (float)((g8.x >> 24) & 0xffu) * k;
                    const float g4 = (float)((g8.y >> 0) & 0xffu) * k, g5 = (float)((g8.y >> 8) & 0xffu) * k, g6 = (float)((g8.y >> 16) & 0xffu) * k, g7 = (float)((g8.y >> 24) & 0xffu) * k;
                    if (PASS == 0) {
                        r[0] = g0 * v0[0]; r[1] = g1 * v0[1]; r[2] = g2 * v0[2]; r[3] = g3 * v0[3]; r[4] = g4 * v1[0]; r[5] = g5 * v1[1]; r[6] = g6 * v1[2]; r[7] = g7 * v1[3];
                    } else {
                        const u32x4 t = *(const u32x4*)(rowp + bj * 128);
                        r[0] = bflo(t.x) + g0 * v0[0]; r[1] = bfhi(t.x) + g1 * v0[1]; r[2] = bflo(t.y) + g2 * v0[2]; r[3] = bfhi(t.y) + g3 * v0[3];
                        r[4] = bflo(t.z) + g4 * v1[0]; r[5] = bfhi(t.z) + g5 * v1[1]; r[6] = bflo(t.w) + g6 * v1[2]; r[7] = bfhi(t.w) + g7 * v1[3];
                    }
                    u32x4 w; w.x = pkbf(r[0], r[1]); w.y = pkbf(r[2], r[3]); w.z = pkbf(r[4], r[5]); w.w = pkbf(r[6], r[7]);
                    *(u32x4*)(rowp + bj * 128) = w; } }
    }
};
struct EpiMergeK {
    static constexpr bool PERM = true, AFTER_DRAIN = false, MIDHOOK = true;
    bf16_t* Z;
    __device__ __forceinline__ void mid(f32x4 (&acc)[2][2][4][2], const pg8::Unit& u, int wr, int wc, int fr, int fq) const {
        unsigned off = (unsigned)((u.pm * 256 + wr * 64 + fr) * ZW + ZMA) * 2u + (unsigned)(u.pn * 256 + wc * 32 + 8 * fq);
        const unsigned char* zb = (const unsigned char*)Z;
#pragma unroll
        for (int ai = 0; ai < 2; ++ai)
#pragma unroll
            for (int m = 0; m < 4; ++m) {
#pragma unroll
                for (int bj = 0; bj < 2; ++bj) { asm volatile("" : "+v"(off));
                    const unsigned o2 = off + (unsigned)((ai * 128 + m * 16) * ZW * 2 + bj * 128);
                    const u32x2 a8 = __builtin_nontemporal_load((const u32x2*)(zb + o2)), b8 = *(const u32x2*)(zb + o2 + 2048);
#pragma unroll
                    for (int e = 0; e < 4; ++e) { const float ga0 = (float)((a8.x >> (8 * e)) & 0xffu), gb0 = fmaxf((float)((b8.x >> (8 * e)) & 0xffu), 1.f), ga1 = (float)((a8.y >> (8 * e)) & 0xffu), gb1 = fmaxf((float)((b8.y >> (8 * e)) & 0xffu), 1.f);
                        acc[ai][bj][m][0][e] *= ga0 * __builtin_amdgcn_rcpf(gb0); acc[ai][bj][m][1][e] *= ga1 * __builtin_amdgcn_rcpf(gb1); }
                    asm volatile("" ::: "memory"); } }
    }
    __device__ __forceinline__ void operator()(const f32x4 (&acc)[2][2][4][2], const pg8::Unit& u, int wr, int wc, int fr, int fq) const {
        const int row0 = u.pm * 256 + wr * 64 + fr, col0 = u.pn * 256 + wc * 32 + 8 * fq;
#pragma unroll
        for (int ai = 0; ai < 2; ++ai)
#pragma unroll
            for (int m = 0; m < 4; ++m) { bf16_t* rowz = Z + (size_t)(row0 + ai * 128 + m * 16) * ZW; const unsigned char* gb = (const unsigned char*)(rowz + ZMA) + 2048 + col0; bf16_t* rowp = rowz + ZMB + col0;
#pragma unroll
                for (int bj = 0; bj < 2; ++bj) { const f32x4 v0 = acc[ai][bj][m][0], v1 = acc[ai][bj][m][1]; const u32x2 b8 = __builtin_nontemporal_load((const u32x2*)(gb + bj * 128)); const float k = 1.f / 255.f; float r[8];
#pragma unroll
                    for (int e = 0; e < 4; ++e) { r[e] = v0[e] * (fmaxf((float)((b8.x >> (8 * e)) & 0xffu), 1.f) * k); r[4 + e] = v1[e] * (fmaxf((float)((b8.y >> (8 * e)) & 0xffu), 1.f) * k); }
                    u32x4 w; w.x = pkbf(r[0], r[1]); w.y = pkbf(r[2], r[3]); w.z = pkbf(r[4], r[5]); w.w = pkbf(r[6], r[7]);
                    *(u32x4*)(rowp + bj * 128) = w; } }
    }
};
struct EpiOut {
    static constexpr bool PERM = true, AFTER_DRAIN = false, MIDHOOK = false;
    const float* xp; const float* xs; float* out;
    __device__ __forceinline__ void operator()(const f32x4 (&acc)[2][2][4][2], const pg8::Unit& u, int wr, int wc, int fr, int fq) const {
        const int row0 = u.pm * 256 + wr * 64 + fr, col0 = u.pn * 256 + wc * 32 + 8 * fq;
#pragma unroll
        for (int ai = 0; ai < 2; ++ai)
#pragma unroll
            for (int m = 0; m < 4; ++m) { const int row = row0 + ai * 128 + m * 16;
                const float* xr = (row < NP_TOK ? xp + (size_t)row * DM : xs + (size_t)(row - NP_TOK) * DM) + col0; bf16_t* orow = (bf16_t*)(out + (size_t)row * DM) + col0;
#pragma unroll
                for (int bj = 0; bj < 2; ++bj) { const f32x4 v0 = __builtin_nontemporal_load((const f32x4*)(xr + bj * 128)) + acc[ai][bj][m][0], v1 = __builtin_nontemporal_load((const f32x4*)(xr + bj * 128 + 4)) + acc[ai][bj][m][1];
                    u32x4 w; w.x = pkbf(v0[0], v0[1]); w.y = pkbf(v0[2], v0[3]); w.z = pkbf(v1[0], v1[1]); w.w = pkbf(v1[2], v1[3]);
                    *(u32x4*)(orow + bj * 128) = w; } }
    }
};

constexpr int L_MU = 125184, L_KC = 126464, L_T = 127232, L_GT = 129280;
constexpr int TS = 384;
constexpr int L_R = 0, L_K = 256, L_V = 512, L_W = 768, L_A = 1024, L_B = 1280, L_TW = 98304, L_AD = 107520, L_Y = 116736, L_BON = 124928;
struct ScanOps { f32x4 a, b, k, r; float v; };
__device__ __forceinline__ void swap16(float& a, float& b) { asm("s_nop 1\n\tv_permlane16_swap_b32 %0, %1" : "+v"(a), "+v"(b)); }
__device__ __forceinline__ float swap16_sum_rows(f32x2 p) {
    float x = p.x, y = p.y; swap16(x, y);
    return rowsum16(x + y);
}
__device__ __forceinline__ f32x2 swap16_sum_bcast(f32x2 p) {
    const float s = swap16_sum_rows(p);
    float x = s, y = s; swap16(x, y);
    return (f32x2){x, y};
}
__device__ __forceinline__ void copy_outputs(const Ctx& C) {
    const int gt = C.bid * 512 + C.tid, NGT = C.G * 512;
    for (int e = gt; e < 8 * SHIFT_W; e += NGT) { const int b = e / SHIFT_W, c = e % SHIFT_W; C.out[O_SHP + e] = bf2f(C.Z[((size_t)b * 2048 + 2047) * ZW + (c < 3072 ? c : ZWD + c - 3072)]); }
    for (int e = gt; e < 32 * SHIFT_W; e += NGT) { const int b = e / SHIFT_W, c = e % SHIFT_W; C.out[O_SHS + e] = bf2f(C.Z[((size_t)NP_TOK + b * 64 + 63) * ZW + (c < 3072 ? c : ZWD + c - 3072)]); }
    for (int e4 = gt; e4 < 8 * 128 * 64; e4 += NGT) { const int e = e4 * 4, b = e >> 15, j = (e >> 8) & 127, c = e & 255; const bf16_t* zr = C.Z + ((size_t)b * 2048 + 1920 + j) * ZW;
        const u32x2 k2 = *(const u32x2*)(zr + ZKB + c), v2 = *(const u32x2*)(zr + ZVB + c);
        *(f32x4*)(C.out + O_KP + e) = (f32x4){bflo(k2.x), bfhi(k2.x), bflo(k2.y), bfhi(k2.y)}; *(f32x4*)(C.out + O_VP + e) = (f32x4){bflo(v2.x), bfhi(v2.x), bflo(v2.y), bfhi(v2.y)}; }
    for (int e4 = gt; e4 < 32 * 128 * 64; e4 += NGT) { const int e = e4 * 4, b = e >> 15, j = (e >> 8) & 127, c = e & 255;
        if (j < 64) { *(f32x4*)(C.out + O_KS + e) = *(const f32x4*)(C.cache_k + ((size_t)b * 128 + 64 + j) * 256 + c); *(f32x4*)(C.out + O_VS + e) = *(const f32x4*)(C.cache_v + ((size_t)b * 128 + 64 + j) * 256 + c); }
        else { const bf16_t* zr = C.Z + ((size_t)NP_TOK + b * 64 + (j - 64)) * ZW; const u32x2 k2 = *(const u32x2*)(zr + ZKB + c), v2 = *(const u32x2*)(zr + ZVB + c);
            *(f32x4*)(C.out + O_KS + e) = (f32x4){bflo(k2.x), bfhi(k2.x), bflo(k2.y), bfhi(k2.y)}; *(f32x4*)(C.out + O_VS + e) = (f32x4){bflo(v2.x), bfhi(v2.x), bflo(v2.y), bfhi(v2.y)}; } }
}
struct ScanPre { u32x4 cu[5]; u32x4 pu[5]; };
__device__ __forceinline__ void scan_phase(const Ctx& C) {
    const int tid = C.tid, lane = C.lane, wave = C.wave;
    copy_outputs(C);
    LAS float* sR = (LAS float*)(C.lds + L_R); LAS float* sK = (LAS float*)(C.lds + L_K); LAS float* sV = (LAS float*)(C.lds + L_V);
    LAS float* sW = (LAS float*)(C.lds + L_W); LAS float* sA = (LAS float*)(C.lds + L_A); LAS float* sB = (LAS float*)(C.lds + L_B);
    LAS bf16_t* sTW = (LAS bf16_t*)(C.lds + L_TW); LAS bf16_t* sAD = (LAS bf16_t*)(C.lds + L_AD);
    LAS float* sY = (LAS float*)(C.lds + L_Y); LAS float* sBON = (LAS float*)(C.lds + L_BON);
    for (int it = C.bid; it < 1280; it += C.G) {
        const bool sample = it >= 256; const int s_ = sample ? it - 256 : it;
        const int b = s_ >> 5, h = (s_ >> 1) & 15, half = s_ & 1;
        const int nchunk = sample ? 1 : 32; const size_t row0 = sample ? (size_t)NP_TOK + (size_t)b * 64 : (size_t)b * 2048;
        const int g = lane >> 4, jq = lane & 15, il = 4 * wave + g, i = half * 32 + il;
        float s0 = 0.f, s1 = 0.f, s2 = 0.f, s3 = 0.f;
        if (sample) { const f32x4 r0 = *(const f32x4*)(C.state_wkv + ((size_t)(b * 16 + h) * 64 + i) * 64 + 4 * jq); s0 = r0.x; s1 = r0.y; s2 = r0.z; s3 = r0.w; }
        const int tt = tid >> 3, c8 = (tid & 7) * 8;
        ScanPre pre;
        { LAS float* smu = (LAS float*)(C.lds + L_MU); LAS float* skc = (LAS float*)(C.lds + L_KC);
          if (tid < 320) { const int arr = tid >> 6, c = tid & 63; smu[tid] = C.mu[arr < 3 ? arr * 1024 + h * 64 + c : (arr == 3 ? 3072 + c : 3136 + c)]; }
          else if (tid < 384) skc[tid - 320] = C.k_k[h * 64 + (tid - 320)];
          else if (tid < 448) skc[tid - 320] = C.k_a[h * 64 + (tid - 384)];
          else skc[tid - 320] = C.r_k[h * 64 + (tid - 448)]; }
        const int mat_ = wave >> 2, fr_ = lane & 15, fq_ = lane >> 4;
        bf16x8 lw0[4], lw1[4]; float lbias[4];
        { const bf16_t* wt = (mat_ ? C.WaT : C.WwT) + (size_t)(h * 64 + fr_) * 64 + 8 * fq_; const float* bias = (mat_ ? C.a0 : C.w0) + h * 64 + fr_;
#pragma unroll
          for (int nt = 0; nt < 4; ++nt) { lw0[nt] = *(const bf16x8*)(wt + nt * 16 * 64); lw1[nt] = *(const bf16x8*)(wt + nt * 16 * 64 + 32); lbias[nt] = bias[nt * 16]; } }
#define SCAN_ISSUE_AT(ROW0, HH, CH) do { const int t_ = (CH) * 64 + tt; const bf16_t* zr_ = C.Z + ((ROW0) + t_) * ZW; \
            _Pragma("unroll") for (int arr = 0; arr < 5; ++arr) { const int zcol = arr < 3 ? arr * 1024 + (HH) * 64 + c8 : (arr == 3 ? ZWD + c8 : ZAD + c8); \
                pre.cu[arr] = *(const u32x4*)(zr_ + zcol); pre.pu[arr] = t_ > 0 ? *(const u32x4*)(zr_ - ZW + zcol) : (u32x4){0u, 0u, 0u, 0u}; } } while (0)
#define SCAN_ISSUE(CH) SCAN_ISSUE_AT(row0, h, CH)
        if (it == C.bid) SCAN_ISSUE(0);
        __syncthreads();
        for (int ch = 0; ch < nchunk; ++ch) {
            { const int t = ch * 64 + tt;
#pragma unroll
              for (int arr = 0; arr < 5; ++arr) {
                  const int zcol = arr < 3 ? arr * 1024 + h * 64 + c8 : (arr == 3 ? ZWD + c8 : ZAD + c8);
                  const int ocol = arr < 3 ? zcol : (arr == 3 ? 3072 + c8 : 3136 + c8);
                  const u32x4 cu = pre.cu[arr], pu = pre.pu[arr]; float p[8], pv[8];
                  p[0] = bflo(cu.x); p[1] = bfhi(cu.x); p[2] = bflo(cu.y); p[3] = bfhi(cu.y); p[4] = bflo(cu.z); p[5] = bfhi(cu.z); p[6] = bflo(cu.w); p[7] = bfhi(cu.w);
                  pv[0] = bflo(pu.x); pv[1] = bfhi(pu.x); pv[2] = bflo(pu.y); pv[3] = bfhi(pu.y); pv[4] = bflo(pu.z); pv[5] = bfhi(pu.z); pv[6] = bflo(pu.w); pv[7] = bfhi(pu.w);
                  if (t == 0 && sample) { const f32x4 s0 = *(const f32x4*)(C.state_shift + (size_t)b * SHIFT_W + ocol), s1 = *(const f32x4*)(C.state_shift + (size_t)b * SHIFT_W + ocol + 4);
                      pv[0] = s0.x; pv[1] = s0.y; pv[2] = s0.z; pv[3] = s0.w; pv[4] = s1.x; pv[5] = s1.y; pv[6] = s1.z; pv[7] = s1.w; }
                  const f32x4 m0 = *(const LAS f32x4*)(C.lds + L_MU + (arr * 64 + c8) * 4), m1 = *(const LAS f32x4*)(C.lds + L_MU + (arr * 64 + c8 + 4) * 4);
                  const float mu[8] = {m0.x, m0.y, m0.z, m0.w, m1.x, m1.y, m1.z, m1.w}; float xs[8];
#pragma unroll
                  for (int e = 0; e < 8; ++e) xs[e] = p[e] + mu[e] * (pv[e] - p[e]);
                  if (arr < 3) { LAS float* d = (arr == 0 ? sR : (arr == 1 ? sK : sV)) + tt * TS + c8;
                      *(LAS f32x4*)d = (f32x4){xs[0], xs[1], xs[2], xs[3]}; *(LAS f32x4*)(d + 4) = (f32x4){xs[4], xs[5], xs[6], xs[7]}; }
                  else { if (arr == 3) {
#pragma unroll
                          for (int e = 0; e < 8; ++e) xs[e] = fast_tanh(xs[e]); }
                      u32x4 w; w.x = pkbf(xs[0], xs[1]); w.y = pkbf(xs[2], xs[3]); w.z = pkbf(xs[4], xs[5]); w.w = pkbf(xs[6], xs[7]);
                      *(LAS u32x4*)((arr == 3 ? sTW : sAD) + tt * 72 + c8) = w; }
              } }
            if (ch + 1 < nchunk) SCAN_ISSUE(ch + 1);
            else if (it + C.G < 1280) { const int itn = it + C.G; const bool smp = itn >= 256; const int sn = smp ? itn - 256 : itn; const int nb = sn >> 5, nh = (sn >> 1) & 15;
                const size_t nrow0 = smp ? (size_t)NP_TOK + (size_t)nb * 64 : (size_t)nb * 2048; SCAN_ISSUE_AT(nrow0, nh, 0); }
            __syncthreads();
            { const int mat = wave >> 2, mt = wave & 3, fr = lane & 15, fq = lane >> 4;
              const LAS bf16_t* src = (mat ? sAD : sTW) + (16 * mt + fr) * 72 + 8 * fq;
              const bf16x8 a0f = *(const LAS bf16x8*)src, a1f = *(const LAS bf16x8*)(src + 32);
#pragma unroll
              for (int nt = 0; nt < 4; ++nt) {
                  const bf16x8 b0f = lw0[nt], b1f = lw1[nt];
                  f32x4 acc = (f32x4){0.f, 0.f, 0.f, 0.f};
                  acc = __builtin_amdgcn_mfma_f32_16x16x32_bf16(a0f, b0f, acc, 0, 0, 0);
                  acc = __builtin_amdgcn_mfma_f32_16x16x32_bf16(a1f, b1f, acc, 0, 0, 0);
                  const float bs = lbias[nt]; const int chn = 16 * nt + fr;
#pragma unroll
                  for (int j = 0; j < 4; ++j) { const int tok = 16 * mt + 4 * fq + j; const float pre_ = bs + acc[j]; float o;
                      if (mat == 0) o = __expf(-0.60653065971f * fast_sigmoid(pre_));
                      else o = fast_sigmoid(pre_);
                      (mat ? sB : sW)[tok * TS + chn] = o; } } }
            __syncthreads();
            { LAS float* sT = (LAS float*)(C.lds + L_T); float gacc = 1.f;
#pragma unroll
              for (int i8 = 0; i8 < 8; ++i8) { const int o = (8 * wave + i8) * TS + lane; gacc *= sW[o]; sW[o] = gacc; }
              sT[wave * 64 + lane] = gacc; }
            __syncthreads();
            { const int cq = lane & 15; const f32x4 kkc = *(const LAS f32x4*)(C.lds + L_KC + 16 * cq), kac = *(const LAS f32x4*)(C.lds + L_KC + 256 + 16 * cq), rkc = *(const LAS f32x4*)(C.lds + L_KC + 512 + 16 * cq);
              const LAS float* sT = (const LAS float*)(C.lds + L_T); f32x4 P = (f32x4){1.f, 1.f, 1.f, 1.f};
              for (int w2 = 0; w2 < wave; ++w2) P = P * *(const LAS f32x4*)(sT + w2 * 64 + 4 * cq);
              if (wave == 7 && lane < 16) *(LAS f32x4*)(C.lds + L_GT + 16 * cq) = P * *(const LAS f32x4*)(sT + 7 * 64 + 4 * cq);
#pragma unroll
              for (int i2 = 0; i2 < 2; ++i2) { const int tok = 8 * wave + 4 * i2 + (lane >> 4), o = tok * TS + 4 * cq;
                  const f32x4 ks = *(const LAS f32x4*)(sK + o), al = *(const LAS f32x4*)(sB + o), r = *(const LAS f32x4*)(sR + o); const f32x4 kkr = ks * kkc;
                  const f32x4 gt = *(const LAS f32x4*)(sW + o) * P; f32x4 gp = P; if (tok & 7) gp = *(const LAS f32x4*)(sW + o - TS) * P;
                  const float n2 = rowsum16((kkr.x * kkr.x + kkr.y * kkr.y) + (kkr.z * kkr.z + kkr.w * kkr.w)); const float inv = 1.f / fmaxf(sqrtf(n2), 1e-12f); const f32x4 kk = kkr * inv;
                  const f32x4 kp = ks * (1.f + (al - 1.f) * kac);
                  const f32x4 igt = (f32x4){__builtin_amdgcn_rcpf(gt.x), __builtin_amdgcn_rcpf(gt.y), __builtin_amdgcn_rcpf(gt.z), __builtin_amdgcn_rcpf(gt.w)};
                  *(LAS f32x4*)(sA + o) = -kk * gp; *(LAS f32x4*)(sB + o) = kk * al * igt; *(LAS f32x4*)(sK + o) = kp * igt; *(LAS f32x4*)(sR + o) = r * gt;
                  const f32x4 rk = r * kp * rkc; const float bon = rowsum16((rk.x + rk.y) + (rk.z + rk.w)); if (cq == 0) sBON[tok] = bon; } }
            __syncthreads();
            { const LAS float* pb = sR + 4 * jq; const LAS float* pv = sV + i; LAS float* pY = sY + il;
#define SCAN_LOAD(o, t) do { o.r = *(const LAS f32x4*)(pb + (t) * TS); o.k = *(const LAS f32x4*)(pb + (t) * TS + 64); \
                  o.a = *(const LAS f32x4*)(pb + (t) * TS + 256); o.b = *(const LAS f32x4*)(pb + (t) * TS + 320); o.v = pv[(t) * TS]; } while (0)
#define VMUL(d, x, y) asm("v_mul_f32 %0, %1, %2" : "=v"(d) : "v"(x), "v"(y))
#define VFMA(d, x, y, z) asm("v_fma_f32 %0, %1, %2, %3" : "=v"(d) : "v"(x), "v"(y), "v"(z))
              ScanOps cur, nx1; SCAN_LOAD(cur, 0); SCAN_LOAD(nx1, 1);
              const bool hi8 = (jq & 8) != 0, hi4 = (jq & 4) != 0; LAS float* pYq = sY + il + 32 * (((jq >> 2) & 1) * 2 + (jq >> 3));
#define SCAN_STEP(QV, TT) do { ScanOps nxt; const int tn = (TT) < 62 ? (TT) + 2 : 63; SCAN_LOAD(nxt, tn); \
                  float p; VMUL(p, s0, cur.a.x); VFMA(p, s1, cur.a.y, p); VFMA(p, s2, cur.a.z, p); VFMA(p, s3, cur.a.w, p); \
                  float u0, u1, u2, u3; \
                  VFMA(u0, cur.v, cur.k.x, s0); VFMA(u1, cur.v, cur.k.y, s1); VFMA(u2, cur.v, cur.k.z, s2); VFMA(u3, cur.v, cur.k.w, s3); \
                  const float sa = rowsum16(p); \
                  VFMA(s0, sa, cur.b.x, u0); VFMA(s1, sa, cur.b.y, u1); VFMA(s2, sa, cur.b.z, u2); VFMA(s3, sa, cur.b.w, u3); \
                  VMUL(QV, s0, cur.r.x); VFMA(QV, s1, cur.r.y, QV); VFMA(QV, s2, cur.r.z, QV); VFMA(QV, s3, cur.r.w, QV); \
                  cur = nx1; nx1 = nxt; } while (0)
#pragma unroll 1
              for (int t0 = 0; t0 < 64; t0 += 4) {
                  float q0, q1, q2, q3;
                  SCAN_STEP(q0, t0); SCAN_STEP(q1, t0 + 1); SCAN_STEP(q2, t0 + 2); SCAN_STEP(q3, t0 + 3);
                  float x01 = hi8 ? q1 : q0; const float y01 = hi8 ? q0 : q1; x01 += dpp_f<0x128>(y01);
                  float x23 = hi8 ? q3 : q2; const float y23 = hi8 ? q2 : q3; x23 += dpp_f<0x128>(y23);
                  float x = hi4 ? x23 : x01; const float yy = hi4 ? x01 : x23; x += dpp_f<0x141>(yy);
                  x += dpp_f<0xB1>(x); x += dpp_f<0x4E>(x);
                  pYq[t0 * 32] = x;
              }
              { const f32x4 gT = *(const LAS f32x4*)(C.lds + L_GT + 16 * jq); s0 *= gT.x; s1 *= gT.y; s2 *= gT.z; s3 *= gT.w; } }
#undef SCAN_STEP
            __syncthreads();
            { const int r4i = (tid & 7) * 4; const f32x4 y4 = *(const LAS f32x4*)(sY + tt * 32 + r4i);
              { u32x2 yw; yw.x = pkbf(y4.x, y4.y); yw.y = pkbf(y4.z, y4.w); *(u32x2*)(C.Yraw + (row0 + ch * 64 + tt) * 1024 + h * 64 + half * 32 + r4i) = yw; }
              if (half == 0 && tid < 64) C.bonus[(row0 + ch * 64 + tid) * 16 + h] = sBON[tid]; }
        }
        *(f32x4*)(C.out + (sample ? O_WKVS : O_WKVP) + ((size_t)(b * 16 + h) * 64 + i) * 64 + 4 * jq) = (f32x4){s0, s1, s2, s3};
        __syncthreads();
    }
#undef SCAN_ISSUE
#undef SCAN_ISSUE_AT
#undef SCAN_LOAD
#undef VMUL
#undef VFMA
}

constexpr int L_KS = 0, L_VT = 27648, L_OW = 53248;
__device__ __forceinline__ void load8(const Ctx& C, bool sample, bool isV, int b, int kvh, size_t qrow0, int key, int kmin, int c8, unsigned (&w)[4]) {
    if (key < kmin) { w[0] = w[1] = w[2] = w[3] = 0u; return; }
    if (sample && key < 128) { const float* src = (isV ? C.cache_v : C.cache_k) + ((size_t)(b * 128 + key) * 4 + kvh) * 64 + c8;
        const f32x4 s0 = *(const f32x4*)src, s1 = *(const f32x4*)(src + 4);
        w[0] = pkbf(s0.x, s0.y); w[1] = pkbf(s0.z, s0.w); w[2] = pkbf(s1.x, s1.y); w[3] = pkbf(s1.z, s1.w); return; }
    const u32x4 v = *(const u32x4*)(C.Z + (qrow0 + key - 128) * ZW + (isV ? ZVB : ZKB) + kvh * 64 + c8);
    w[0] = v.x; w[1] = v.y; w[2] = v.z; w[3] = v.w;
}
__device__ __forceinline__ void attn_item(const Ctx& C, int item) {
    const int tid = C.tid, lane = C.lane, wave = C.wave, fr = lane & 15, fq = lane >> 4;
    const bool sample = item >= 1024; int b, c, kvh;
    if (!sample) { b = item >> 7; c = (item >> 2) & 31; kvh = item & 3; } else { const int s = item - 1024; b = s >> 2; kvh = s & 3; c = 2; }
    const size_t qrow0 = sample ? (size_t)NP_TOK + (size_t)b * 64 : (size_t)b * 2048 + (size_t)c * 64;
    const int kmin = sample ? 0 : (c >= 2 ? 0 : 128 - c * 64);
    LAS bf16_t* Ks = (LAS bf16_t*)(C.lds + L_KS); LAS bf16_t* Vt = (LAS bf16_t*)(C.lds + L_VT);
    for (int p = tid; p < 1536; p += 512) {
        unsigned w[4];
        { const int key = p >> 3, c8 = (p & 7) * 8; load8(C, sample, false, b, kvh, qrow0, key, kmin, c8, w);
          *(LAS u32x4*)(Ks + key * 72 + c8) = (u32x4){w[0], w[1], w[2], w[3]}; }
        { const int key = p % 192, d0 = (p / 192) * 8; load8(C, sample, true, b, kvh, qrow0, key, kmin, d0, w);
#pragma unroll
          for (int e = 0; e < 4; ++e) { Vt[(d0 + 2 * e) * 200 + key] = (bf16_t)(w[e] & 0xffffu); Vt[(d0 + 2 * e + 1) * 200 + key] = (bf16_t)(w[e] >> 16); } }
    }
    __syncthreads();
    const int gq = wave >> 1, qh = wave & 1, hq = kvh * 4 + gq;
    const float slope = exp2f(-0.5f * (float)(hq + 1)), sink = C.sinks[hq];
#pragma unroll 1
    for (int nt = 0; nt < 2; ++nt) {
        bf16x8 qf[2];
#pragma unroll
        for (int ks = 0; ks < 2; ++ks) qf[ks] = *(const bf16x8*)(C.Z + (qrow0 + qh * 32 + nt * 16 + fr) * ZW + ZQ + hq * 64 + ks * 32 + 8 * fq);
        f32x4 sacc[12];
#pragma unroll
        for (int kt = 0; kt < 12; ++kt) sacc[kt] = (f32x4){0.f, 0.f, 0.f, 0.f};
#pragma unroll
        for (int kt = 0; kt < 12; ++kt)
#pragma unroll
            for (int ks = 0; ks < 2; ++ks) { const bf16x8 kf = *(const LAS bf16x8*)(Ks + (16 * kt + fr) * 72 + ks * 32 + 8 * fq);
                sacc[kt] = __builtin_amdgcn_mfma_f32_16x16x32_bf16(kf, qf[ks], sacc[kt], 0, 0, 0); }
        bf16x8 pf[6];
        { const float fd = (float)(qh * 32 + nt * 16 + fr + 128 - 4 * fq); float mx = -1e30f;
#pragma unroll
          for (int kt = 0; kt < 12; ++kt)
#pragma unroll
              for (int j = 0; j < 4; ++j) sacc[kt][j] = __builtin_fmaf(-slope, fabsf(fd - (float)(16 * kt + j)), sacc[kt][j]);
          if (kmin > 0) {
#pragma unroll
              for (int kt = 0; kt < 12; ++kt)
#pragma unroll
                  for (int j = 0; j < 4; ++j) { const int key = 16 * kt + 4 * fq + j; sacc[kt][j] = key >= kmin ? sacc[kt][j] : -1e30f; } }
#pragma unroll
          for (int kt = 0; kt < 12; ++kt)
#pragma unroll
              for (int j = 0; j < 4; ++j) mx = fmaxf(mx, sacc[kt][j]);
          mx = fmaxf(mx, __shfl_xor(mx, 16)); mx = fmaxf(mx, __shfl_xor(mx, 32)); mx = fmaxf(mx, sink);
          float sum = 0.f;
#pragma unroll
          for (int kt = 0; kt < 12; ++kt)
#pragma unroll
              for (int j = 0; j < 4; ++j) { const float e = __expf(sacc[kt][j] - mx); sacc[kt][j] = e; sum += e; }
          sum += __shfl_xor(sum, 16); sum += __shfl_xor(sum, 32);
          const float inv = 1.f / (sum + __expf(sink - mx));
#pragma unroll
          for (int kb = 0; kb < 6; ++kb) { const f32x4 e0 = sacc[2 * kb] * inv, e1 = sacc[2 * kb + 1] * inv;
              const u32x4 w = (u32x4){pkbf(e0[0], e0[1]), pkbf(e0[2], e0[3]), pkbf(e1[0], e1[1]), pkbf(e1[2], e1[3])}; pf[kb] = __builtin_bit_cast(bf16x8, w); }
        }
        f32x4 o[4];
#pragma unroll
        for (int nb = 0; nb < 4; ++nb) o[nb] = (f32x4){0.f, 0.f, 0.f, 0.f};
#pragma unroll
        for (int kb = 0; kb < 6; ++kb)
#pragma unroll
            for (int nb = 0; nb < 4; ++nb) { const LAS bf16_t* vp = Vt + (16 * nb + fr) * 200 + 32 * kb + 4 * fq;
                const u32x2 v0 = *(const LAS u32x2*)vp, v1 = *(const LAS u32x2*)(vp + 16);
                const bf16x8 vf = __builtin_bit_cast(bf16x8, ((u32x4){v0.x, v0.y, v1.x, v1.y}));
                o[nb] = __builtin_amdgcn_mfma_f32_16x16x32_bf16(pf[kb], vf, o[nb], 0, 0, 0); }
        { LAS float* Ow = (LAS float*)(C.lds + L_OW) + wave * (16 * 68);
#pragma unroll
          for (int nb = 0; nb < 4; ++nb)
#pragma unroll
              for (int j = 0; j < 4; ++j) Ow[(4 * fq + j) * 68 + 16 * nb + fr] = o[nb][j];
          const int qq = lane >> 2, dc = (lane & 3) * 16; const size_t tok = qrow0 + qh * 32 + 16 * nt + qq;
          const u32x4 g0 = *(const u32x4*)(C.Z + tok * ZW + ZGB + hq * 64 + dc), g1 = *(const u32x4*)(C.Z + tok * ZW + ZGB + hq * 64 + dc + 8);
          const LAS f32x4* orow = (const LAS f32x4*)(Ow + qq * 68 + dc); const f32x4 o0 = orow[0], o1 = orow[1], o2 = orow[2], o3 = orow[3];
          u32x4 w0, w1;
          w0.x = pkbf(o0.x * bflo(g0.x), o0.y * bfhi(g0.x)); w0.y = pkbf(o0.z * bflo(g0.y), o0.w * bfhi(g0.y)); w0.z = pkbf(o1.x * bflo(g0.z), o1.y * bfhi(g0.z)); w0.w = pkbf(o1.z * bflo(g0.w), o1.w * bfhi(g0.w));
          w1.x = pkbf(o2.x * bflo(g1.x), o2.y * bfhi(g1.x)); w1.y = pkbf(o2.z * bflo(g1.y), o2.w * bfhi(g1.y)); w1.z = pkbf(o3.x * bflo(g1.z), o3.y * bfhi(g1.z)); w1.w = pkbf(o3.z * bflo(g1.w), o3.w * bfhi(g1.w));
          bf16_t* yp = C.Ya + tok * 2048 + 1024 + hq * 64 + dc; *(u32x4*)yp = w0; *(u32x4*)(yp + 8) = w1; }
    }
    __syncthreads();
}
__device__ __forceinline__ void phase3(const Ctx& C) {
    for (int it = C.bid; it < 1152; it += C.G) attn_item(C, it);
    const int gw = C.bid * 8 + C.wave, NGW = C.G * 8, lane = C.lane;
    for (int wi0 = gw; wi0 < MTOK * 16 / 4; wi0 += 4 * NGW) {
        u32x2 yc[4]; f32x4 y4[4]; u32x2 vc[4], vp[4], gc[4]; float bon[4];
#pragma unroll
        for (int u = 0; u < 4; ++u) { const int wi = wi0 + u * NGW; if (wi < MTOK * 16 / 4) {
            const int pr = wi * 4 + (lane >> 4), tok = pr >> 4, h = pr & 15, col = h * 64 + 4 * (lane & 15); const bf16_t* zr = C.Z + (size_t)tok * ZW;
            yc[u] = __builtin_nontemporal_load((const u32x2*)(C.Yraw + (size_t)tok * 1024 + col)); vc[u] = *(const u32x2*)(zr + ZV + col); vp[u] = *(const u32x2*)(zr - (tok > 0 ? ZW : 0) + ZV + col);
            gc[u] = *(const u32x2*)(zr + ZGA + col); bon[u] = C.bonus[(size_t)tok * 16 + h]; } }
#pragma unroll
        for (int u = 0; u < 4; ++u) { const int wi = wi0 + u * NGW; if (wi < MTOK * 16 / 4) {
            const int pr = wi * 4 + (lane >> 4), tok = pr >> 4, h = pr & 15, col = h * 64 + 4 * (lane & 15);
            y4[u] = (f32x4){bflo(yc[u].x), bfhi(yc[u].x), bflo(yc[u].y), bfhi(yc[u].y)};
            const float mean = rowsum16((y4[u].x + y4[u].y) + (y4[u].z + y4[u].w)) * (1.f / 64.f); const f32x4 d = y4[u] - mean;
            const float var = rowsum16((d.x * d.x + d.y * d.y) + (d.z * d.z + d.w * d.w)) * (1.f / 64.f); const float rstd = rsqrtf(var + 64e-5f);
            const f32x4 v = (f32x4){bflo(vc[u].x), bfhi(vc[u].x), bflo(vc[u].y), bfhi(vc[u].y)}; f32x4 pv = (f32x4){bflo(vp[u].x), bfhi(vp[u].x), bflo(vp[u].y), bfhi(vp[u].y)};
            const int tin = tok < NP_TOK ? (tok & 2047) : ((tok - NP_TOK) & 63);
            if (tin == 0) { if (tok >= NP_TOK) pv = *(const f32x4*)(C.state_shift + (size_t)((tok - NP_TOK) >> 6) * SHIFT_W + 2048 + col); else pv = (f32x4){0.f, 0.f, 0.f, 0.f}; }
            const f32x4 mu4 = *(const f32x4*)(C.mu + 2048 + col); const f32x4 vs = v + mu4 * (pv - v);
            const f32x4 g4 = (f32x4){bflo(gc[u].x), bfhi(gc[u].x), bflo(gc[u].y), bfhi(gc[u].y)};
            const f32x4 lw = *(const f32x4*)(C.lnx_w + col), lb = *(const f32x4*)(C.lnx_b + col);
            const f32x4 o = (d * rstd * lw + lb + vs * bon[u]) * g4;
            u32x2 w; w.x = pkbf(o.x, o.y); w.y = pkbf(o.z, o.w); *(u32x2*)(C.Ya + (size_t)tok * 2048 + col) = w; } }
    }
}

__device__ __forceinline__ void phase6(const Ctx& C) {
    const int gw = C.bid * 8 + C.wave, NGW = C.G * 8;
    int m = gw; u32x4 v[4], vn[4];
    if (m >= MTOK) return;
    { const u32x4* xr = (const u32x4*)(C.out + (size_t)m * DM) + C.lane;
#pragma unroll
      for (int j = 0; j < 4; ++j) v[j] = xr[64 * j]; }
    for (;;) { const int mn = m + NGW; const bool more = mn < MTOK;
        if (more) { const u32x4* xn = (const u32x4*)(C.out + (size_t)mn * DM) + C.lane;
#pragma unroll
            for (int j = 0; j < 4; ++j) vn[j] = xn[64 * j]; }
        f32x4 f[4][2]; float s = 0.f;
#pragma unroll
        for (int j = 0; j < 4; ++j) { f[j][0] = (f32x4){bflo(v[j].x), bfhi(v[j].x), bflo(v[j].y), bfhi(v[j].y)}; f[j][1] = (f32x4){bflo(v[j].z), bfhi(v[j].z), bflo(v[j].w), bfhi(v[j].w)};
            s += (f[j][0].x * f[j][0].x + f[j][0].y * f[j][0].y) + (f[j][0].z * f[j][0].z + f[j][0].w * f[j][0].w) + (f[j][1].x * f[j][1].x + f[j][1].y * f[j][1].y) + (f[j][1].z * f[j][1].z + f[j][1].w * f[j][1].w); }
        const float rs = rsqrtf(wave_sum(s) * (1.f / DM) + 1e-6f);
        const f32x4* gr = (const f32x4*)C.g_final + 2 * C.lane; f32x4* orow = (f32x4*)(C.out + (size_t)m * DM) + 2 * C.lane;
#pragma unroll
        for (int j = 0; j < 4; ++j) { orow[128 * j] = f[j][0] * rs * gr[128 * j]; orow[128 * j + 1] = f[j][1] * rs * gr[128 * j + 1]; }
        if (!more) break;
#pragma unroll
        for (int j = 0; j < 4; ++j) v[j] = vn[j];
        m = mn; }
}

#define XB_TMO      128
#define XB_XCNT(j)  (256  + 64 * (j))
#define XB_XSUB(j)  (1280 + 64 * (j))
#define XB_XGEN(j)  (2304 + 64 * (j))
#define XB_TOP      3328
#define XB_TOPGEN   3392
#define XCD_BAR_WORDS 3456
#define XB_SPIN_CAP (1u << 18)

__device__ __forceinline__ unsigned xb_ld(unsigned* p)              { return __hip_atomic_load(p, __ATOMIC_RELAXED, __HIP_MEMORY_SCOPE_AGENT); }
__device__ __forceinline__ unsigned xb_add(unsigned* p, unsigned v) { return __hip_atomic_fetch_add(p, v, __ATOMIC_RELAXED, __HIP_MEMORY_SCOPE_AGENT); }
__device__ __forceinline__ unsigned xb_xcc_id() { return (unsigned)__builtin_amdgcn_s_getreg((3 << 11) | 20) & 0xFu; }
#define XB_SPIN(cond, bar) do { unsigned _sp = 0; while (cond) { __builtin_amdgcn_s_sleep(1); \
    if ((++_sp & 255u) == 0u) { if (xb_ld(&(bar)[XB_TMO])) break; if (_sp > XB_SPIN_CAP) { atomicAdd(&(bar)[XB_TMO], 1u); break; } } } } while (0)

struct XcdBarrier {
    unsigned* bar; unsigned x;
    volatile LAS unsigned* st;
};

__device__ __forceinline__ XcdBarrier xcd_barrier_post(unsigned* bar, volatile LAS unsigned* st) {
    XcdBarrier b; b.bar = bar; b.x = xb_xcc_id(); b.st = st;
    if (threadIdx.x == 0) (void)xb_add(&bar[XB_XCNT(b.x)], 1u);
    return b;
}
__device__ __forceinline__ void xcd_barrier_complete(unsigned* bar, unsigned x, unsigned& nloc, unsigned& nx) {
    const unsigned G = gridDim.x * gridDim.y * gridDim.z;
    unsigned sum, cnt, mine, sp = 0u;
    for (;;) {
        sum = 0u; cnt = 0u; mine = 0u;
#pragma unroll
        for (unsigned j = 0; j < 16; ++j) { const unsigned c = xb_ld(&bar[XB_XCNT(j)]); sum += c; cnt += (c > 0u) ? 1u : 0u; mine = (j == x) ? c : mine; }
        if (sum == G) break;
        __builtin_amdgcn_s_sleep(1);
        if ((++sp & 255u) == 0u) { if (xb_ld(&bar[XB_TMO])) break; if (sp > XB_SPIN_CAP) { atomicAdd(&bar[XB_TMO], 1u); break; } }
    }
    nloc = mine > 0u ? mine : 1u; nx = cnt > 0u ? cnt : 1u;
}

__device__ __forceinline__ void xcd_barrier(const XcdBarrier& b) {
    asm volatile("s_waitcnt vmcnt(0)" ::: "memory");
    __syncthreads();
    if (threadIdx.x == 0) {
        unsigned* bar = b.bar;
        __builtin_amdgcn_s_waitcnt(0);
        unsigned nloc = b.st[0], nx = b.st[1];
        if (nloc == 0u) { xcd_barrier_complete(bar, b.x, nloc, nx); b.st[0] = nloc; b.st[1] = nx; }
        const unsigned old = xb_add(&bar[XB_XSUB(b.x)], 1u);
        const unsigned gen = old / nloc;
        if (old + 1u == (gen + 1u) * nloc) {
            __builtin_amdgcn_fence(__ATOMIC_RELEASE, "agent");
            asm volatile("s_waitcnt vmcnt(0)" ::: "memory");
            const unsigned og = xb_add(&bar[XB_TOP], 1u);
            const unsigned tg = og / nx;
            if (og + 1u == (tg + 1u) * nx) xb_add(&bar[XB_TOPGEN], 1u);
            else XB_SPIN(xb_ld(&bar[XB_TOPGEN]) == tg, bar);
            __builtin_amdgcn_fence(__ATOMIC_ACQUIRE, "agent");
            xb_add(&bar[XB_XGEN(b.x)], 1u);
            asm volatile("s_waitcnt vmcnt(0)" ::: "memory");
        } else {
            XB_SPIN(xb_ld(&bar[XB_XGEN(b.x)]) == gen, bar);
            __builtin_amdgcn_fence(__ATOMIC_ACQUIRE, "agent");
            asm volatile("s_waitcnt vmcnt(0)" ::: "memory");
        }
    }
    __syncthreads();
}

__global__ void __launch_bounds__(512, 2) mega_fwd(Args a) {
    extern __shared__ __attribute__((aligned(16))) unsigned char lds_raw[];
    cg::grid_group grid = cg::this_grid();
    Ctx C;
    C.x_prompt = a.in[0]; C.x_sample = a.in[1]; C.state_wkv = a.in[2]; C.state_shift = a.in[3]; C.cache_k = a.in[4]; C.cache_v = a.in[5]; C.g_norm = a.in[6]; C.w_in = a.in[7];
    C.mu = a.in[8]; C.w0 = a.in[9]; C.w_w_up = a.in[10]; C.a0 = a.in[11]; C.w_a_up = a.in[12]; C.k_k = a.in[13]; C.k_a = a.in[14]; C.r_k = a.in[15]; C.lnx_w = a.in[16]; C.lnx_b = a.in[17];
    C.sinks = a.in[18]; C.p_a = a.in[19]; C.p_b = a.in[20]; C.w_o = a.in[21]; C.g_final = a.in[22];
    C.out = a.out; C.ws = a.ws;
    C.WinT = (bf16_t*)(a.ws + WS_WIN); C.PaT = (bf16_t*)(a.ws + WS_PA); C.PbT = (bf16_t*)(a.ws + WS_PB); C.WoT = (bf16_t*)(a.ws + WS_WO);
    C.WwT = (bf16_t*)(a.ws + WS_WW); C.WaT = (bf16_t*)(a.ws + WS_WA); C.bonus = (float*)(a.ws + WS_BON); C.Z = (bf16_t*)(a.ws + WS_Z);
    C.H = (bf16_t*)((unsigned char*)a.out + DO_H); C.Yraw = (bf16_t*)((unsigned char*)a.out + DO_YRAW); C.Ya = (bf16_t*)((unsigned char*)a.out + DO_YA); C.Yb = (bf16_t*)((unsigned char*)a.out + DO_YB);
    C.lds = (LAS unsigned char*)lds_raw;
    C.tid = threadIdx.x; C.lane = C.tid & 63; C.wave = __builtin_amdgcn_readfirstlane(C.tid >> 6); C.G = gridDim.x; C.bid = blockIdx.x;
    const int lo = a.ph_lo, hi = a.ph_hi;
    volatile LAS unsigned* misc = (volatile LAS unsigned*)(C.lds + L_MISC);
    if (C.tid < 2) misc[C.tid] = 0u;
    __syncthreads();
    XcdBarrier bar; bar.bar = (unsigned*)(a.ws + WS_BAR); bar.x = 0; bar.st = nullptr;
    if (hi - lo > 1) bar = xcd_barrier_post((unsigned*)(a.ws + WS_BAR), misc);
    if (lo > hi) grid.sync();
#define IN(k) (lo <= (k) && (k) < hi)
#define SEAM(k) do { if (IN(k) && IN((k) + 1)) xcd_barrier(bar); } while (0)
    if (IN(0)) phase0(C);
    SEAM(0);
    if (IN(1)) { pg8::Gemm g{C.H, C.WinT, MTOK, ZW, DM, DM}; pg8::StaticOrder S; S.init(MTOK, ZW, C.G, C.bid); EpiZ E{C.Z};
        pg8::gemm_phase<EpiZ, pg8::StaticOrder, true, true>(C.lds, g, S, E);
        { const int first = (72 * 43) % C.G, nidle = C.G - first; if (C.bid >= first) tr_run(C, (LAS float*)(C.lds + C.wave * 16384), (C.bid - first) * 8 + C.wave, nidle * 8, 1); } }
    SEAM(1);
    if (IN(2)) scan_phase(C);
    SEAM(2);
    if (IN(3)) phase3(C);
    SEAM(3);
    if (IN(4)) {
        { pg8::Gemm g{C.Ya, C.PaT, MTOK, DM, 2048, 2048}; pg8::StaticOrder S; S.init(MTOK, DM, C.G, C.bid); EpiMergeK E{C.Z};
          pg8::gemm_phase<EpiMergeK, pg8::StaticOrder, true, true>(C.lds, g, S, E); }
    }
    SEAM(4);
    if (IN(5)) { pg8::Gemm g{C.Z + ZMB, C.WoT, MTOK, DM, DM, ZW}; pg8::StaticOrder S; S.init(MTOK, DM, C.G, C.bid); EpiOut E{C.x_prompt, C.x_sample, C.out};
        pg8::gemm_phase<EpiOut, pg8::StaticOrder, true, true>(C.lds, g, S, E); }
    SEAM(5);
    if (IN(6)) phase6(C);
#undef IN
#undef SEAM
}

extern "C" void kernel_launch(void* const* d_in, const int* in_sizes, int n_in, void* d_out, int out_size, void* d_ws, size_t ws_size, hipStream_t stream) {
    static int grid = 0;
    if (grid == 0) {
        if (n_in != 23 || (size_t)out_size != O_END || ws_size < WS_END) { fprintf(stderr, "kernel_launch: unexpected sizes: n_in %d out %d ws %zu (need %zu)\n", n_in, out_size, ws_size, (size_t)WS_END); grid = -1; return; }
        int dev = 0, cus = 0, per_cu = 0;
        if (hipGetDevice(&dev) != hipSuccess || hipDeviceGetAttribute(&cus, hipDeviceAttributeMultiprocessorCount, dev) != hipSuccess) { grid = -1; return; }
        if (hipFuncSetAttribute((const void*)mega_fwd, hipFuncAttributeMaxDynamicSharedMemorySize, LDS_BYTES) != hipSuccess) { fprintf(stderr, "kernel_launch: hipFuncSetAttribute failed\n"); grid = -1; return; }
        if (hipOccupancyMaxActiveBlocksPerMultiprocessor(&per_cu, (const void*)mega_fwd, 512, LDS_BYTES) != hipSuccess || per_cu < 1) { fprintf(stderr, "kernel_launch: occupancy query failed (%d)\n", per_cu); (void)hipGetLastError(); grid = -1; return; }
        grid = cus * per_cu;
        fprintf(stderr, "kernel_launch: %d CUs x %d = grid %d\n", cus, per_cu, grid);
    }
    if (grid < 0) return;
    if (hipMemsetAsync((char*)d_ws + WS_BAR, 0, BAR_BYTES, stream) != hipSuccess) { fprintf(stderr, "kernel_launch: hipMemsetAsync failed\n"); return; }
    Args a{};
    for (int i = 0; i < 23; ++i) a.in[i] = (const float*)d_in[i];
    a.out = (float*)d_out; a.ws = (unsigned char*)d_ws;
#if MK_MULTI
    for (int k = 0; k < NPHASE; ++k) { a.ph_lo = k; a.ph_hi = k + 1; hipLaunchKernelGGL(mega_fwd, dim3(grid), dim3(512), LDS_BYTES, stream, a); }
#else
    a.ph_lo = 0; a.ph_hi = NPHASE;
    void* args[] = {&a};
    const hipError_t e = hipLaunchCooperativeKernel((const void*)mega_fwd, dim3(grid), dim3(512), args, LDS_BYTES, stream);
    if (e != hipSuccess) fprintf(stderr, "kernel_launch: cooperative launch failed: %s (grid %d)\n", hipGetErrorString(e), grid);
#endif
}
```

```cpp
#include <hip/hip_runtime.h>
#include <hip/hip_cooperative_groups.h>
#include <cstdio>
#include <cstdint>
namespace cg = cooperative_groups;

#ifndef MK_MULTI
#define MK_MULTI 0
#endif

namespace pg8 {
#define PG8_LAS __attribute__((address_space(3)))
typedef unsigned short bf16_t;
typedef short bf16x8 __attribute__((ext_vector_type(8)));
typedef float f32x4 __attribute__((ext_vector_type(4)));
typedef unsigned u32x4 __attribute__((ext_vector_type(4)));
constexpr int BM = 256, BK = 64, HALF = 128, HTB = HALF * BK * 2, STAGE_BYTES = 8 * HTB, NXCD = 8, WGM = 4;
__host__ __device__ __forceinline__ int lds_byte(int r, int c) { const int st = (r >> 4) * 2 + (c >> 5), rr = r & 15, cc = c & 31, ob = rr * 64 + cc * 2; return st * 1024 + (ob ^ (((ob >> 9) & 1) << 5)); }
__host__ __device__ __forceinline__ void stage_rc(int b, int& R, int& C) { const int st = b / 1024, sb = b % 1024, swz = sb ^ (((sb >> 9) & 1) << 5); R = (st >> 1) * 16 + swz / 64; C = (st & 1) * 32 + (swz % 64) / 2; }
__host__ __device__ __forceinline__ int perm32(int rho) { const int n = rho >> 4, i = rho & 15; return 8 * (i >> 2) + 4 * n + (i & 3); }
struct Unit { int pm, pn; };
struct Gemm { const bf16_t* A; const bf16_t* Bt; int M, N, K, lda; };
struct StaticOrder {
    int nM, nN, nwg, G, c;
    __host__ __device__ void init(int M, int N, int G_, int c_) { nM = M / BM; nN = N / BM; nwg = nM * nN; G = G_; c = c_; }
    __host__ __device__ bool next(int i, Unit& u) const {
        const long L = (long)i * G + c; if (L >= nwg) return false;
        int wgid = (int)L; { const int q = nwg / NXCD, r = nwg % NXCD, xcd = wgid % NXCD, off = wgid / NXCD; wgid = (xcd < r ? xcd * (q + 1) : r * (q + 1) + (xcd - r) * q) + off; }
        const int nig = WGM * nN, gid = wgid / nig, fm = gid * WGM, gsz = (nM - fm) < WGM ? (nM - fm) : WGM;
        u.pm = fm + ((wgid % nig) % gsz); u.pn = (wgid % nig) / gsz; return true;
    }
    __device__ __forceinline__ void a_ready(const Unit&) const {}
    __device__ __forceinline__ void done(const Unit&) const {}
};
__device__ __forceinline__ unsigned cvt_pk_bf16(float lo, float hi) { unsigned r; asm volatile("v_cvt_pk_bf16_f32 %0, %1, %2" : "=v"(r) : "v"(lo), "v"(hi)); return r; }
template <class Epi, class Sched, bool ALIGN_EPI = false, bool SP2 = false>
__device__ __forceinline__ void gemm_phase(PG8_LAS unsigned char* lds, const Gemm g, const Sched& S, const Epi& E) {
    const int tid = threadIdx.x, wid = __builtin_amdgcn_readfirstlane(tid >> 6), lane = tid & 63, wr = wid >> 2, wc = wid & 3, fr = lane & 15, fq = lane >> 4;
    const int K = g.K, nt = K / BK;
    unsigned voffA[2], voffB[2];
#pragma unroll
    for (int i = 0; i < 2; ++i) { int R, C; stage_rc(tid * 16 + i * 8192, R, C); const int Rb = Epi::PERM ? ((R & ~31) + perm32(R & 31)) : R;
        voffA[i] = (unsigned)(R * g.lda + C) * 2u; voffB[i] = (unsigned)(Rb * K + C) * 2u; }
    const size_t kstep = (size_t)(BK * 2);
    const size_t hstepB = (size_t)HALF * K * 2, hstepA = (size_t)HALF * g.lda * 2;
    const size_t tstepB = 2 * hstepB, tstepA = 2 * hstepA;
    const unsigned ldsw = (unsigned)wid * 1024u;
    const int aoff = lds_byte(wr * 64 + fr, fq * 8), boff = lds_byte(wc * 32 + fr, fq * 8);
#define PG8_SA(b, h) (((b) * 2 + (h)) * HTB)
#define PG8_SB(b, h) ((4 + (b) * 2 + (h)) * HTB)
#define PG8_STAGE(bufoff, gbase, voff) do { _Pragma("unroll") for (int _i = 0; _i < 2; ++_i) \
        __builtin_amdgcn_global_load_lds((const unsigned*)((const char*)(gbase) + (voff)[_i]), (PG8_LAS unsigned*)(lds + (bufoff) + ldsw + _i * 8192), 16, 0, 0); } while (0)
#define PG8_LDA(dst, b, h) do { _Pragma("unroll") for (int m = 0; m < 4; ++m) _Pragma("unroll") for (int k = 0; k < 2; ++k) dst[m][k] = *(const PG8_LAS bf16x8*)(lds + PG8_SA(b, h) + aoff + m * 2048 + k * 1024); } while (0)
#define PG8_LDB(dst, b, h) do { _Pragma("unroll") for (int n = 0; n < 2; ++n) _Pragma("unroll") for (int k = 0; k < 2; ++k) dst[n][k] = *(const PG8_LAS bf16x8*)(lds + PG8_SB(b, h) + boff + n * 2048 + k * 1024); } while (0)
#define PG8_MMA(ai, bj, At, Bt) do { __builtin_amdgcn_s_setprio(1); _Pragma("unroll") for (int m = 0; m < 4; ++m) _Pragma("unroll") for (int n = 0; n < 2; ++n) _Pragma("unroll") for (int k = 0; k < 2; ++k) \
        acc[ai][bj][m][n] = __builtin_amdgcn_mfma_f32_16x16x32_bf16(Bt[n][k], At[m][k], acc[ai][bj][m][n], 0, 0, 0); __builtin_amdgcn_s_setprio(0); } while (0)
#define PG8_WAIT_V(n) asm volatile("s_waitcnt vmcnt(" #n ")" ::: "memory")
#define PG8_WAIT_L(n) asm volatile("s_waitcnt lgkmcnt(" #n ")" ::: "memory")
#define PG8_BAR __builtin_amdgcn_s_barrier()
#define PG8_SCHED __builtin_amdgcn_sched_barrier(0)
    Unit cur, nxt; int ui = 0;
    if (!S.next(0, cur)) return;
    f32x4 acc[2][2][4][2];
#pragma unroll
    for (int a = 0; a < 2; ++a)
#pragma unroll
        for (int b = 0; b < 2; ++b)
#pragma unroll
            for (int m = 0; m < 4; ++m)
#pragma unroll
                for (int n = 0; n < 2; ++n) acc[a][b][m][n] = (f32x4){0.f, 0.f, 0.f, 0.f};
    bf16x8 At[4][2], B0[2][2], B1[2][2];
    const char* cA = (const char*)g.A + (size_t)cur.pm * tstepA; const char* cB = (const char*)g.Bt + (size_t)cur.pn * tstepB;
    S.a_ready(cur);
    if constexpr (SP2) {
        PG8_STAGE(PG8_SB(0, 0), cB, voffB); PG8_STAGE(PG8_SB(0, 1), cB + hstepB, voffB); PG8_STAGE(PG8_SA(0, 0), cA, voffA); PG8_STAGE(PG8_SA(0, 1), cA + hstepA, voffA);
        if (wr == 1) PG8_BAR;
        PG8_WAIT_V(2); PG8_BAR;
        PG8_STAGE(PG8_SB(1, 0), cB + kstep, voffB); PG8_STAGE(PG8_SA(1, 0), cA + kstep, voffA); PG8_STAGE(PG8_SB(1, 1), cB + hstepB + kstep, voffB);
        PG8_WAIT_V(6); PG8_BAR;
    } else {
        PG8_STAGE(PG8_SB(0, 0), cB, voffB); PG8_STAGE(PG8_SA(0, 0), cA, voffA); PG8_STAGE(PG8_SB(0, 1), cB + hstepB, voffB); PG8_STAGE(PG8_SA(0, 1), cA + hstepA, voffA);
        if (wr == 1) PG8_BAR;
        PG8_WAIT_V(4); PG8_BAR;
        PG8_STAGE(PG8_SB(1, 0), cB + kstep, voffB); PG8_STAGE(PG8_SA(1, 0), cA + kstep, voffA); PG8_STAGE(PG8_SB(1, 1), cB + hstepB + kstep, voffB);
        PG8_WAIT_V(6); PG8_BAR;
    }
    for (;;) {
        const bool has_next = S.next(ui + 1, nxt);
        const char* nA = has_next ? (const char*)g.A + (size_t)nxt.pm * tstepA : cA; const char* nB = has_next ? (const char*)g.Bt + (size_t)nxt.pn * tstepB : cB;
        for (int t = 0; t < nt; t += 2) {
            const bool last = (t == nt - 2);
            if constexpr (Epi::MIDHOOK) { if (t == nt / 2) { asm volatile("" ::: "memory"); __builtin_amdgcn_sched_barrier(0); E.mid(acc, cur, wr, wc, fr, fq); asm volatile("" ::: "memory"); __builtin_amdgcn_sched_barrier(0); } }
            const char* a1 = cA + (size_t)(t + 1) * kstep;
            const char* a2 = last ? nA : cA + (size_t)(t + 2) * kstep; const char* b2 = last ? nB : cB + (size_t)(t + 2) * kstep;
            const char* a3 = a2 + kstep; const char* b3 = b2 + kstep;
            if (last && has_next) S.a_ready(nxt);
            if constexpr (SP2) {
            PG8_LDB(B0, 0, 0); PG8_LDB(B1, 0, 1); PG8_SCHED; PG8_LDA(At, 0, 0); PG8_STAGE(PG8_SA(1, 1), a1 + hstepA, voffA);
            PG8_WAIT_V(8); PG8_WAIT_L(0); PG8_BAR; PG8_MMA(0, 0, At, B0); PG8_MMA(0, 1, At, B1); PG8_BAR; PG8_SCHED;
            PG8_LDA(At, 0, 1); PG8_STAGE(PG8_SB(0, 0), b2, voffB); PG8_STAGE(PG8_SB(0, 1), b2 + hstepB, voffB); PG8_STAGE(PG8_SA(0, 0), a2, voffA);
            PG8_WAIT_V(8); PG8_WAIT_L(0); PG8_BAR; PG8_MMA(1, 0, At, B0); PG8_MMA(1, 1, At, B1); PG8_BAR; PG8_SCHED;
            PG8_LDB(B0, 1, 0); PG8_LDB(B1, 1, 1); PG8_SCHED; PG8_LDA(At, 1, 0); PG8_STAGE(PG8_SA(0, 1), a2 + hstepA, voffA);
            PG8_WAIT_V(8); PG8_WAIT_L(0); PG8_BAR; PG8_MMA(0, 0, At, B0); PG8_MMA(0, 1, At, B1); PG8_BAR; PG8_SCHED;
            PG8_LDA(At, 1, 1); PG8_STAGE(PG8_SB(1, 0), b3, voffB); PG8_STAGE(PG8_SB(1, 1), b3 + hstepB, voffB); PG8_STAGE(PG8_SA(1, 0), a3, voffA);
            PG8_WAIT_V(8); PG8_WAIT_L(0); PG8_BAR; PG8_MMA(1, 0, At, B0); PG8_MMA(1, 1, At, B1); PG8_BAR; PG8_SCHED;
            } else {
            PG8_LDB(B0, 0, 0); PG8_SCHED; PG8_LDA(At, 0, 0); PG8_STAGE(PG8_SA(1, 1), a1 + hstepA, voffA);
            PG8_WAIT_L(8); PG8_BAR; PG8_WAIT_L(0); PG8_MMA(0, 0, At, B0); PG8_BAR; PG8_SCHED;
            PG8_LDB(B1, 0, 1); PG8_STAGE(PG8_SB(0, 0), b2, voffB);
            PG8_BAR; PG8_WAIT_L(0); PG8_MMA(0, 1, At, B1); PG8_BAR;
            PG8_LDA(At, 0, 1); PG8_STAGE(PG8_SA(0, 0), a2, voffA);
            PG8_BAR; PG8_WAIT_L(0); PG8_MMA(1, 0, At, B0); PG8_BAR; PG8_SCHED;
            PG8_STAGE(PG8_SB(0, 1), b2 + hstepB, voffB);
            PG8_WAIT_V(6); PG8_BAR; PG8_MMA(1, 1, At, B1); PG8_BAR;
            PG8_LDB(B0, 1, 0); PG8_SCHED; PG8_LDA(At, 1, 0); PG8_STAGE(PG8_SA(0, 1), a2 + hstepA, voffA);
            PG8_WAIT_L(8); PG8_BAR; PG8_WAIT_L(0); PG8_MMA(0, 0, At, B0); PG8_BAR; PG8_SCHED;
            PG8_LDB(B1, 1, 1); PG8_STAGE(PG8_SB(1, 0), b3, voffB);
            PG8_BAR; PG8_WAIT_L(0); PG8_MMA(0, 1, At, B1); PG8_BAR;
            PG8_LDA(At, 1, 1); PG8_STAGE(PG8_SA(1, 0), a3, voffA);
            PG8_BAR; PG8_WAIT_L(0); PG8_MMA(1, 0, At, B0); PG8_BAR; PG8_SCHED;
            PG8_STAGE(PG8_SB(1, 1), b3 + hstepB, voffB);
            PG8_WAIT_V(6); PG8_BAR; PG8_MMA(1, 1, At, B1); PG8_BAR;
            }
        }
        if constexpr (ALIGN_EPI) { if (wr == 0) PG8_BAR; }
        if constexpr (!Epi::AFTER_DRAIN) { E(acc, cur, wr, wc, fr, fq); S.done(cur); }
        if (!has_next) break;
#pragma unroll
        for (int a = 0; a < 2; ++a)
#pragma unroll
            for (int b = 0; b < 2; ++b)
#pragma unroll
                for (int m = 0; m < 4; ++m)
#pragma unroll
                    for (int n = 0; n < 2; ++n) acc[a][b][m][n] = (f32x4){0.f, 0.f, 0.f, 0.f};
        cur = nxt; cA = nA; cB = nB; ++ui;
        if constexpr (ALIGN_EPI) { if (wr == 1) PG8_BAR; }
    }
    PG8_WAIT_V(0);
    if constexpr (!ALIGN_EPI) { if (wr == 0) PG8_BAR; }
    PG8_BAR;
    if constexpr (Epi::AFTER_DRAIN) { E.fused(acc, cur, wr, wc, fr, fq, lds, wid, lane); S.done(cur); }
#undef PG8_SA
#undef PG8_SB
#undef PG8_STAGE
#undef PG8_LDA
#undef PG8_LDB
#undef PG8_MMA
#undef PG8_WAIT_V
#undef PG8_WAIT_L
#undef PG8_BAR
#undef PG8_SCHED
}
}

#define LAS __attribute__((address_space(3)))
typedef unsigned short bf16_t;
typedef short bf16x8 __attribute__((ext_vector_type(8)));
typedef float f32x4 __attribute__((ext_vector_type(4)));
typedef float f32x2 __attribute__((ext_vector_type(2)));
typedef unsigned u32x4 __attribute__((ext_vector_type(4)));
typedef unsigned u32x2 __attribute__((ext_vector_type(2)));

constexpr int DM = 2048, NP_TOK = 16384, MTOK = 18432, SHIFT_W = 3200;
constexpr int ZW = 11008;
constexpr int ZR = 0, ZK = 1024, ZV = 2048, ZGA = 3072, ZQ = 4096, ZKB = 5120, ZVB = 5376, ZGB = 5632, ZMA = 6656, ZMB = 8704, ZWD = 10752, ZAD = 10816;
constexpr size_t MiB = 1u << 20;
constexpr size_t WS_WIN = 0, WS_PA = 43 * MiB, WS_PB = 47 * MiB, WS_WO = 51 * MiB, WS_WW = 59 * MiB, WS_WA = 59 * MiB + 131072, WS_BON = 60 * MiB, WS_Z = 64 * MiB;
constexpr size_t WS_END = WS_Z + (size_t)MTOK * ZW * 2;
constexpr size_t WS_BAR = 63 * MiB, BAR_BYTES = 16384;
constexpr int L_MISC = 147200;
constexpr size_t DO_H = 0, DO_YRAW = 0, DO_YA = 72 * MiB, DO_YB = 108 * MiB;
constexpr size_t O_WKVP = 37748736, O_SHP = O_WKVP + 524288, O_KP = O_SHP + 25600, O_VP = O_KP + 262144, O_WKVS = O_VP + 262144, O_SHS = O_WKVS + 2097152, O_KS = O_SHS + 102400, O_VS = O_KS + 1048576, O_END = O_VS + 1048576;
constexpr int LDS_BYTES = 147456;
constexpr int NPHASE = 7;

struct Args { const float* in[23]; float* out; unsigned char* ws; int ph_lo, ph_hi; };

struct Ctx {
    const float *x_prompt, *x_sample, *state_wkv, *state_shift, *cache_k, *cache_v, *g_norm, *w_in, *mu, *w0, *w_w_up, *a0, *w_a_up, *k_k, *k_a, *r_k, *lnx_w, *lnx_b, *sinks, *p_a, *p_b, *w_o, *g_final;
    float* out; unsigned char* ws;
    bf16_t *WinT, *PaT, *PbT, *WoT, *WwT, *WaT, *Z, *H, *Ya, *Yb, *Yraw; float *bonus;
    LAS unsigned char* lds;
    int tid, lane, wave, G, bid;
};

__device__ __forceinline__ float bflo(unsigned u) { return __uint_as_float(u << 16); }
__device__ __forceinline__ float bfhi(unsigned u) { return __uint_as_float(u & 0xffff0000u); }
__device__ __forceinline__ float bf2f(bf16_t b) { return __uint_as_float((unsigned)b << 16); }
__device__ __forceinline__ unsigned pkbf(float lo, float hi) { return pg8::cvt_pk_bf16(lo, hi); }
__device__ __forceinline__ float wave_sum(float v) {
#pragma unroll
    for (int o = 1; o < 64; o <<= 1) v += __shfl_xor(v, o);
    return v;
}
template <int CTRL> __device__ __forceinline__ float dpp_f(float v) { return __builtin_bit_cast(float, __builtin_amdgcn_update_dpp(0, __builtin_bit_cast(int, v), CTRL, 0xF, 0xF, true)); }
__device__ __forceinline__ float rowsum16(float v) {
    v += dpp_f<0xB1>(v);
    v += dpp_f<0x4E>(v);
    v += dpp_f<0x141>(v);
    v += dpp_f<0x140>(v);
    return v;
}
__device__ __forceinline__ float fast_sigmoid(float x) { return __builtin_amdgcn_rcpf(1.f + __expf(-x)); }
__device__ __forceinline__ float fast_silu(float x) { return x * fast_sigmoid(x); }
__device__ __forceinline__ float fast_tanh(float x) { return 1.f - 2.f * __builtin_amdgcn_rcpf(1.f + __expf(2.f * x)); }
__device__ __forceinline__ const float* xrow(const Ctx& C, int m) { return m < NP_TOK ? C.x_prompt + (size_t)m * DM : C.x_sample + (size_t)(m - NP_TOK) * DM; }
#define LDS_WAIT() asm volatile("s_waitcnt lgkmcnt(0)" ::: "memory")

struct TrItem { const float* src; bf16_t* dst; int N, K; bool zero; };
__device__ __forceinline__ TrItem tr_item(const Ctx& C, int it) {
    constexpr int I_IN = 32 * 344, I_P = 16 * 64, I_O = 32 * 64, I_L = 32;
    TrItem t; int r = it; t.zero = false;
    if (r < I_IN) { const int kb = r / 344, nb = r % 344, zc = 32 * nb; const int src = zc < 3072 ? zc : (zc < 10752 ? zc + 128 : (zc < 10880 ? zc - 10752 + 3072 : -1));
        t.N = 10880; t.K = 2048; t.zero = src < 0; t.src = C.w_in + (size_t)(64 * kb) * 10880 + (src < 0 ? 0 : src); t.dst = C.WinT + (size_t)zc * 2048 + 64 * kb; return t; } r -= I_IN;
    if (r < I_P) { t.N = 2048; t.K = 2048; t.src = C.p_a + (size_t)(64 * (r / 64)) * 2048 + 32 * (r % 64); t.dst = C.PaT + (size_t)(32 * (r % 64)) * 2048 + 64 * (r / 64); return t; } r -= I_P;
    if (r < I_P) { t.N = 2048; t.K = 2048; t.src = C.p_b + (size_t)(64 * (r / 64)) * 2048 + 32 * (r % 64); t.dst = C.PaT + (size_t)(32 * (r % 64)) * 2048 + 1024 + 64 * (r / 64); return t; } r -= I_P;
    if (r < I_O) { t.N = 2048; t.K = 2048; t.src = C.w_o + (size_t)(64 * (r / 64)) * 2048 + 32 * (r % 64); t.dst = C.WoT + (size_t)(32 * (r % 64)) * 2048 + 64 * (r / 64); return t; } r -= I_O;
    if (r < I_L) { t.N = 1024; t.K = 64; t.src = C.w_w_up + 32 * r; t.dst = C.WwT + (size_t)(32 * r) * 64; return t; } r -= I_L;
    t.N = 1024; t.K = 64; t.src = C.w_a_up + 32 * r; t.dst = C.WaT + (size_t)(32 * r) * 64; return t;
}
__device__ __forceinline__ void tr_load(const TrItem& t, int lane, float (&v)[32]) {
#pragma unroll
    for (int i = 0; i < 32; ++i) v[i] = t.zero ? 0.f : __builtin_nontemporal_load(t.src + (size_t)(2 * i + (lane >> 5)) * t.N + (lane & 31));
}
__device__ __forceinline__ void tr_store(const TrItem& t, int lane, const float (&v)[32], LAS float* scr) {
#pragma unroll
    for (int i = 0; i < 32; ++i) scr[(2 * i + (lane >> 5)) * 33 + (lane & 31)] = v[i];
    LDS_WAIT(); asm volatile("" ::: "memory");
    const int c = lane & 7;
#pragma unroll
    for (int j = 0; j < 4; ++j) { const int n = (lane >> 3) + 8 * j; const LAS float* s = scr + (8 * c) * 33 + n;
        u32x4 o; o.x = pkbf(s[0 * 33], s[1 * 33]); o.y = pkbf(s[2 * 33], s[3 * 33]); o.z = pkbf(s[4 * 33], s[5 * 33]); o.w = pkbf(s[6 * 33], s[7 * 33]);
        *(u32x4*)(t.dst + (size_t)n * t.K + 8 * c) = o; }
    LDS_WAIT(); asm volatile("" ::: "memory");
}
__device__ __forceinline__ void tr_run(const Ctx& C, LAS float* scr, int w0, int nw, int set) {
    constexpr int I_IN = 32 * 344, I_MID = 2 * 16 * 64 + 32 * 64, I_L = 2 * 32;
    const int n = set == 0 ? I_IN + I_L : I_MID;
    float va[32], vb[32]; int it = w0;
    if (it >= n) return;
#define TR_ID(i) (set == 0 ? ((i) < I_IN ? (i) : (i) + I_MID) : (i) + I_IN)
    TrItem ta = tr_item(C, TR_ID(it)); tr_load(ta, C.lane, va);
    for (;;) { const int itn = it + nw; const bool more = itn < n; TrItem tb = ta;
        if (more) { tb = tr_item(C, TR_ID(itn)); tr_load(tb, C.lane, vb); }
        tr_store(ta, C.lane, va, scr);
        if (!more) break;
#pragma unroll
        for (int i = 0; i < 32; ++i) va[i] = vb[i];
        ta = tb; it = itn; }
#undef TR_ID
}
__device__ __forceinline__ void phase0(const Ctx& C) {
    LAS float* scr = (LAS float*)(C.lds + C.wave * 16384);
    const int gw = C.bid * 8 + C.wave, NGW = C.G * 8;
    tr_run(C, scr, gw, NGW, 0);
    {
      int m = gw; f32x4 v[8], vn[8];
      if (m < MTOK) { const f32x4* xr = (const f32x4*)xrow(C, m) + C.lane;
#pragma unroll
          for (int j = 0; j < 8; ++j) v[j] = __builtin_nontemporal_load(xr + 64 * j);
          for (;;) { const int mn = m + NGW; const bool more = mn < MTOK;
              if (more) { const f32x4* xn = (const f32x4*)xrow(C, mn) + C.lane;
#pragma unroll
                  for (int j = 0; j < 8; ++j) vn[j] = __builtin_nontemporal_load(xn + 64 * j); }
              float s = 0.f;
#pragma unroll
              for (int j = 0; j < 8; ++j) s += (v[j].x * v[j].x + v[j].y * v[j].y) + (v[j].z * v[j].z + v[j].w * v[j].w);
              const float rs = rsqrtf(wave_sum(s) * (1.f / DM) + 1e-6f);
              u32x2* o8 = (u32x2*)(C.H + (size_t)m * DM) + C.lane; const f32x4* gr = (const f32x4*)C.g_norm + C.lane;
#pragma unroll
              for (int j = 0; j < 8; ++j) { const f32x4 g = gr[64 * j]; u32x2 w; w.x = pkbf(v[j].x * rs * g.x, v[j].y * rs * g.y); w.y = pkbf(v[j].z * rs * g.z, v[j].w * rs * g.w); o8[64 * j] = w; }
              if (!more) break;
#pragma unroll
              for (int j = 0; j < 8; ++j) v[j] = vn[j];
              m = mn; } } }
}

struct EpiZ {
    static constexpr bool PERM = true, AFTER_DRAIN = false, MIDHOOK = false;
    bf16_t* Z;
    __device__ __forceinline__ void operator()(const f32x4 (&acc)[2][2][4][2], const pg8::Unit& u, int wr, int wc, int fr, int fq) const {
        const int pn = u.pn; const int act = (pn >= 12 && pn < 16) || (pn >= 22 && pn < 26) ? 1 : ((pn >= 26 && pn < 42) ? 2 : ((pn >= 16 && pn < 20) ? 3 : 0));
        const int row0 = u.pm * 256 + wr * 64 + fr, col0 = pn * 256 + wc * 32 + 8 * fq;
#pragma unroll
        for (int ai = 0; ai < 2; ++ai)
#pragma unroll
            for (int m = 0; m < 4; ++m) { bf16_t* rowp = Z + (size_t)(row0 + ai * 128 + m * 16) * ZW + col0;
#pragma unroll
                for (int bj = 0; bj < 2; ++bj) { f32x4 v0 = acc[ai][bj][m][0], v1 = acc[ai][bj][m][1];
                    if (act == 1) {
#pragma unroll
                        for (int e = 0; e < 4; ++e) { v0[e] = fast_silu(v0[e]); v1[e] = fast_silu(v1[e]); } }
                    else if (act == 2) {
#pragma unroll
                        for (int e = 0; e < 4; ++e) { v0[e] = fast_sigmoid(v0[e]); v1[e] = fast_sigmoid(v1[e]); } }
                    else if (act == 3) { v0 = v0 * 0.125f; v1 = v1 * 0.125f; }
                    if (act == 2) {
                        unsigned lo = 0u, hi = 0u;
                        lo = __builtin_amdgcn_cvt_pk_u8_f32(__builtin_rintf(v0[0] * 255.f), 0, lo); lo = __builtin_amdgcn_cvt_pk_u8_f32(__builtin_rintf(v0[1] * 255.f), 1, lo); lo = __builtin_amdgcn_cvt_pk_u8_f32(__builtin_rintf(v0[2] * 255.f), 2, lo); lo = __builtin_amdgcn_cvt_pk_u8_f32(__builtin_rintf(v0[3] * 255.f), 3, lo);
                        hi = __builtin_amdgcn_cvt_pk_u8_f32(__builtin_rintf(v1[0] * 255.f), 0, hi); hi = __builtin_amdgcn_cvt_pk_u8_f32(__builtin_rintf(v1[1] * 255.f), 1, hi); hi = __builtin_amdgcn_cvt_pk_u8_f32(__builtin_rintf(v1[2] * 255.f), 2, hi); hi = __builtin_amdgcn_cvt_pk_u8_f32(__builtin_rintf(v1[3] * 255.f), 3, hi);
                        unsigned char* gb = (unsigned char*)(Z + (size_t)(row0 + ai * 128 + m * 16) * ZW + ZMA) + (pn >= 34 ? 2048 + (pn - 34) * 256 : (pn - 26) * 256) + wc * 32 + 8 * fq + bj * 128;
                        *(u32x2*)gb = (u32x2){lo, hi};
                    } else {
                    u32x4 w; w.x = pkbf(v0[0], v0[1]); w.y = pkbf(v0[2], v0[3]); w.z = pkbf(v1[0], v1[1]); w.w = pkbf(v1[2], v1[3]);
                    *(u32x4*)(rowp + bj * 128) = w; } } }
    }
};
template <int PASS> struct EpiMerge {
    static constexpr bool PERM = true, AFTER_DRAIN = false, MIDHOOK = false;
    bf16_t* Z;
    __device__ __forceinline__ void operator()(const f32x4 (&acc)[2][2][4][2], const pg8::Unit& u, int wr, int wc, int fr, int fq) const {
        const int row0 = u.pm * 256 + wr * 64 + fr, col0 = u.pn * 256 + wc * 32 + 8 * fq;
#pragma unroll
        for (int ai = 0; ai < 2; ++ai)
#pragma unroll
            for (int m = 0; m < 4; ++m) { bf16_t* rowz = Z + (size_t)(row0 + ai * 128 + m * 16) * ZW; const unsigned char* gb = (const unsigned char*)(rowz + ZMA) + (PASS ? 2048 : 0) + col0; bf16_t* rowp = rowz + ZMB + col0;
#pragma unroll
                for (int bj = 0; bj < 2; ++bj) { const f32x4 v0 = acc[ai][bj][m][0], v1 = acc[ai][bj][m][1];
                    const u32x2 g8 = __builtin_nontemporal_load((const u32x2*)(gb + bj * 128)); const float k = 1.f / 255.f; float r[8];
                    const float g0 = (float)((g8.x >> 0) & 0xffu) * k, g1 = (float)((g8.x >> 8) & 0xffu) * k, g2 = (float)((g8.x >> 16) & 0xffu) * k, g3 = (float)((g8.x >> 24) & 0xffu) * k;
                    const float g4 = (float)((g8.y >> 0) & 0xffu) * k, g5 = (float)((g8.y >> 8) & 0xffu) * k, g6 = (float)((g8.y >> 16) & 0xffu) * k, g7 = (float)((g8.y >> 24) & 0xffu) * k;
                    if (PASS == 0) {
                        r[0] = g0 * v0[0]; r[1] = g1 * v0[1]; r[2] = g2 * v0[2]; r[3] = g3 * v0[3]; r[4] = g4 * v1[0]; r[5] = g5 * v1[1]; r[6] = g6 * v1[2]; r[7] = g7 * v1[3];
                    } else {
                        const u32x4 t = *(const u32x4*)(rowp + bj * 128);
                        r[0] = bflo(t.x) + g0 * v0[0]; r[1] = bfhi(t.x) + g1 * v0[1]; r[2] = bflo(t.y) + g2 * v0[2]; r[3] = bfhi(t.y) + g3 * v0[3];
                        r[4] = bflo(t.z) + g4 * v1[0]; r[5] = bfhi(t.z) + g5 * v1[1]; r[6] = bflo(t.w) + g6 * v1[2]; r[7] = bfhi(t.w) + g7 * v1[3];
                    }
                    u32x4 w; w.x = pkbf(r[0], r[1]); w.y = pkbf(r[2], r[3]); w.z = pkbf(r[4], r[5]); w.w = pkbf(r[6], r[7]);
                    *(u32x4*)(rowp + bj * 128) = w; } }
    }
};
struct EpiMergeK {
    static constexpr bool PERM = true, AFTER_DRAIN = false, MIDHOOK = true;
    bf16_t* Z;
    __device__ __forceinline__ void mid(f32x4 (&acc)[2][2][4][2], const pg8::Unit& u, int wr, int wc, int fr, int fq) const {
        unsigned off = (unsigned)((u.pm * 256 + wr * 64 + fr) * ZW + ZMA) * 2u + (unsigned)(u.pn * 256 + wc * 32 + 8 * fq);
        const unsigned char* zb = (const unsigned char*)Z;
#pragma unroll
        for (int ai = 0; ai < 2; ++ai)
#pragma unroll
            for (int m = 0; m < 4; ++m) {
#pragma unroll
                for (int bj = 0; bj < 2; ++bj) { asm volatile("" : "+v"(off));
                    const unsigned o2 = off + (unsigned)((ai * 128 + m * 16) * ZW * 2 + bj * 128);
                    const u32x2 a8 = __builtin_nontemporal_load((const u32x2*)(zb + o2)), b8 = *(const u32x2*)(zb + o2 + 2048);
#pragma unroll
                    for (int e = 0; e < 4; ++e) { const float ga0 = (float)((a8.x >> (8 * e)) & 0xffu), gb0 = fmaxf((float)((b8.x >> (8 * e)) & 0xffu), 1.f), ga1 = (float)((a8.y >> (8 * e)) & 0xffu), gb1 = fmaxf((float)((b8.y >> (8 * e)) & 0xffu), 1.f);
                        acc[ai][bj][m][0][e] *= ga0 * __builtin_amdgcn_rcpf(gb0); acc[ai][bj][m][1][e] *= ga1 * __builtin_amdgcn_rcpf(gb1); }
                    asm volatile("" ::: "memory"); } }
    }
    __device__ __forceinline__ void operator()(const f32x4 (&acc)[2][2][4][2], const pg8::Unit& u, int wr, int wc, int fr, int fq) const {
        const int row0 = u.pm * 256 + wr * 64 + fr, col0 = u.pn * 256 + wc * 32 + 8 * fq;
#pragma unroll
        for (int ai = 0; ai < 2; ++ai)
#pragma unroll
            for (int m = 0; m < 4; ++m) { bf16_t* rowz = Z + (size_t)(row0 + ai * 128 + m * 16) * ZW; const unsigned char* gb = (const unsigned char*)(rowz + ZMA) + 2048 + col0; bf16_t* rowp = rowz + ZMB + col0;
#pragma unroll
                for (int bj = 0; bj < 2; ++bj) { const f32x4 v0 = acc[ai][bj][m][0], v1 = acc[ai][bj][m][1]; const u32x2 b8 = *(const u32x2*)(gb + bj * 128); const float k = 1.f / 255.f; float r[8];
#pragma unroll
                    for (int e = 0; e < 4; ++e) { r[e] = v0[e] * (fmaxf((float)((b8.x >> (8 * e)) & 0xffu), 1.f) * k); r[4 + e] = v1[e] * (fmaxf((float)((b8.y >> (8 * e)) & 0xffu), 1.f) * k); }
                    u32x4 w; w.x = pkbf(r[0], r[1]); w.y = pkbf(r[2], r[3]); w.z = pkbf(r[4], r[5]); w.w = pkbf(r[6], r[7]);
                    *(u32x4*)(rowp + bj * 128) = w; } }
    }
};
struct EpiOut {
    static constexpr bool PERM = true, AFTER_DRAIN = false, MIDHOOK = false;
    const float* xp; const float* xs; float* out;
    __device__ __forceinline__ void operator()(const f32x4 (&acc)[2][2][4][2], const pg8::Unit& u, int wr, int wc, int fr, int fq) const {
        const int row0 = u.pm * 256 + wr * 64 + fr, col0 = u.pn * 256 + wc * 32 + 8 * fq;
#pragma unroll
        for (int ai = 0; ai < 2; ++ai)
#pragma unroll
            for (int m = 0; m < 4; ++m) { const int row = row0 + ai * 128 + m * 16;
                const float* xr = (row < NP_TOK ? xp + (size_t)row * DM : xs + (size_t)(row - NP_TOK) * DM) + col0; bf16_t* orow = (bf16_t*)(out + (size_t)row * DM) + col0;
#pragma unroll
                for (int bj = 0; bj < 2; ++bj) { const f32x4 v0 = __builtin_nontemporal_load((const f32x4*)(xr + bj * 128)) + acc[ai][bj][m][0], v1 = __builtin_nontemporal_load((const f32x4*)(xr + bj * 128 + 4)) + acc[ai][bj][m][1];
                    u32x4 w; w.x = pkbf(v0[0], v0[1]); w.y = pkbf(v0[2], v0[3]); w.z = pkbf(v1[0], v1[1]); w.w = pkbf(v1[2], v1[3]);
                    *(u32x4*)(orow + bj * 128) = w; } }
    }
};

constexpr int L_MU = 125184, L_KC = 126464, L_T = 127232, L_GT = 129280;
constexpr int TS = 384;
constexpr int L_R = 0, L_K = 256, L_V = 512, L_W = 768, L_A = 1024, L_B = 1280, L_TW = 98304, L_AD = 107520, L_Y = 116736, L_BON = 124928;
struct ScanOps { f32x4 a, b, k, r; float v; };
__device__ __forceinline__ void swap16(float& a, float& b) { asm("s_nop 1\n\tv_permlane16_swap_b32 %0, %1" : "+v"(a), "+v"(b)); }
__device__ __forceinline__ float swap16_sum_rows(f32x2 p) {
    float x = p.x, y = p.y; swap16(x, y);
    return rowsum16(x + y);
}
__device__ __forceinline__ f32x2 swap16_sum_bcast(f32x2 p) {
    const float s = swap16_sum_rows(p);
    float x = s, y = s; swap16(x, y);
    return (f32x2){x, y};
}
__device__ __forceinline__ void copy_outputs(const Ctx& C) {
    const int gt = C.bid * 512 + C.tid, NGT = C.G * 512;
    for (int e = gt; e < 8 * SHIFT_W; e += NGT) { const int b = e / SHIFT_W, c = e % SHIFT_W; C.out[O_SHP + e] = bf2f(C.Z[((size_t)b * 2048 + 2047) * ZW + (c < 3072 ? c : ZWD + c - 3072)]); }
    for (int e = gt; e < 32 * SHIFT_W; e += NGT) { const int b = e / SHIFT_W, c = e % SHIFT_W; C.out[O_SHS + e] = bf2f(C.Z[((size_t)NP_TOK + b * 64 + 63) * ZW + (c < 3072 ? c : ZWD + c - 3072)]); }
    for (int e4 = gt; e4 < 8 * 128 * 64; e4 += NGT) { const int e = e4 * 4, b = e >> 15, j = (e >> 8) & 127, c = e & 255; const bf16_t* zr = C.Z + ((size_t)b * 2048 + 1920 + j) * ZW;
        const u32x2 k2 = *(const u32x2*)(zr + ZKB + c), v2 = *(const u32x2*)(zr + ZVB + c);
        *(f32x4*)(C.out + O_KP + e) = (f32x4){bflo(k2.x), bfhi(k2.x), bflo(k2.y), bfhi(k2.y)}; *(f32x4*)(C.out + O_VP + e) = (f32x4){bflo(v2.x), bfhi(v2.x), bflo(v2.y), bfhi(v2.y)}; }
    for (int e4 = gt; e4 < 32 * 128 * 64; e4 += NGT) { const int e = e4 * 4, b = e >> 15, j = (e >> 8) & 127, c = e & 255;
        if (j < 64) { *(f32x4*)(C.out + O_KS + e) = *(const f32x4*)(C.cache_k + ((size_t)b * 128 + 64 + j) * 256 + c); *(f32x4*)(C.out + O_VS + e) = *(const f32x4*)(C.cache_v + ((size_t)b * 128 + 64 + j) * 256 + c); }
        else { const bf16_t* zr = C.Z + ((size_t)NP_TOK + b * 64 + (j - 64)) * ZW; const u32x2 k2 = *(const u32x2*)(zr + ZKB + c), v2 = *(const u32x2*)(zr + ZVB + c);
            *(f32x4*)(C.out + O_KS + e) = (f32x4){bflo(k2.x), bfhi(k2.x), bflo(k2.y), bfhi(k2.y)}; *(f32x4*)(C.out + O_VS + e) = (f32x4){bflo(v2.x), bfhi(v2.x), bflo(v2.y), bfhi(v2.y)}; } }
}
struct ScanPre { u32x4 cu[5]; u32x4 pu[5]; };
__device__ __forceinline__ void scan_phase(const Ctx& C) {
    const int tid = C.tid, lane = C.lane, wave = C.wave;
    copy_outputs(C);
    LAS float* sR = (LAS float*)(C.lds + L_R); LAS float* sK = (LAS float*)(C.lds + L_K); LAS float* sV = (LAS float*)(C.lds + L_V);
    LAS float* sW = (LAS float*)(C.lds + L_W); LAS float* sA = (LAS float*)(C.lds + L_A); LAS float* sB = (LAS float*)(C.lds + L_B);
    LAS bf16_t* sTW = (LAS bf16_t*)(C.lds + L_TW); LAS bf16_t* sAD = (LAS bf16_t*)(C.lds + L_AD);
    LAS float* sY = (LAS float*)(C.lds + L_Y); LAS float* sBON = (LAS float*)(C.lds + L_BON);
    for (int it = C.bid; it < 1280; it += C.G) {
        const bool sample = it >= 256; const int s_ = sample ? it - 256 : it;
        const int b = s_ >> 5, h = (s_ >> 1) & 15, half = s_ & 1;
        const int nchunk = sample ? 1 : 32; const size_t row0 = sample ? (size_t)NP_TOK + (size_t)b * 64 : (size_t)b * 2048;
        const int g = lane >> 4, jq = lane & 15, il = 4 * wave + g, i = half * 32 + il;
        float s0 = 0.f, s1 = 0.f, s2 = 0.f, s3 = 0.f;
        if (sample) { const f32x4 r0 = *(const f32x4*)(C.state_wkv + ((size_t)(b * 16 + h) * 64 + i) * 64 + 4 * jq); s0 = r0.x; s1 = r0.y; s2 = r0.z; s3 = r0.w; }
        const int tt = tid >> 3, c8 = (tid & 7) * 8;
        ScanPre pre;
        { LAS float* smu = (LAS float*)(C.lds + L_MU); LAS float* skc = (LAS float*)(C.lds + L_KC);
          if (tid < 320) { const int arr = tid >> 6, c = tid & 63; smu[tid] = C.mu[arr < 3 ? arr * 1024 + h * 64 + c : (arr == 3 ? 3072 + c : 3136 + c)]; }
          else if (tid < 384) skc[tid - 320] = C.k_k[h * 64 + (tid - 320)];
          else if (tid < 448) skc[tid - 320] = C.k_a[h * 64 + (tid - 384)];
          else skc[tid - 320] = C.r_k[h * 64 + (tid - 448)]; }
        const int mat_ = wave >> 2, fr_ = lane & 15, fq_ = lane >> 4;
        bf16x8 lw0[4], lw1[4]; float lbias[4];
        { const bf16_t* wt = (mat_ ? C.WaT : C.WwT) + (size_t)(h * 64 + fr_) * 64 + 8 * fq_; const float* bias = (mat_ ? C.a0 : C.w0) + h * 64 + fr_;
#pragma unroll
          for (int nt = 0; nt < 4; ++nt) { lw0[nt] = *(const bf16x8*)(wt + nt * 16 * 64); lw1[nt] = *(const bf16x8*)(wt + nt * 16 * 64 + 32); lbias[nt] = bias[nt * 16]; } }
#define SCAN_ISSUE_AT(ROW0, HH, CH) do { const int t_ = (CH) * 64 + tt; const bf16_t* zr_ = C.Z + ((ROW0) + t_) * ZW; \
            _Pragma("unroll") for (int arr = 0; arr < 5; ++arr) { const int zcol = arr < 3 ? arr * 1024 + (HH) * 64 + c8 : (arr == 3 ? ZWD + c8 : ZAD + c8); \
                pre.cu[arr] = *(const u32x4*)(zr_ + zcol); pre.pu[arr] = t_ > 0 ? *(const u32x4*)(zr_ - ZW + zcol) : (u32x4){0u, 0u, 0u, 0u}; } } while (0)
#define SCAN_ISSUE(CH) SCAN_ISSUE_AT(row0, h, CH)
        if (it == C.bid) SCAN_ISSUE(0);
        __syncthreads();
        for (int ch = 0; ch < nchunk; ++ch) {
            { const int t = ch * 64 + tt;
#pragma unroll
              for (int arr = 0; arr < 5; ++arr) {
                  const int zcol = arr < 3 ? arr * 1024 + h * 64 + c8 : (arr == 3 ? ZWD + c8 : ZAD + c8);
                  const int ocol = arr < 3 ? zcol : (arr == 3 ? 3072 + c8 : 3136 + c8);
                  const u32x4 cu = pre.cu[arr], pu = pre.pu[arr]; float p[8], pv[8];
                  p[0] = bflo(cu.x); p[1] = bfhi(cu.x); p[2] = bflo(cu.y); p[3] = bfhi(cu.y); p[4] = bflo(cu.z); p[5] = bfhi(cu.z); p[6] = bflo(cu.w); p[7] = bfhi(cu.w);
                  pv[0] = bflo(pu.x); pv[1] = bfhi(pu.x); pv[2] = bflo(pu.y); pv[3] = bfhi(pu.y); pv[4] = bflo(pu.z); pv[5] = bfhi(pu.z); pv[6] = bflo(pu.w); pv[7] = bfhi(pu.w);
                  if (t == 0 && sample) { const f32x4 s0 = *(const f32x4*)(C.state_shift + (size_t)b * SHIFT_W + ocol), s1 = *(const f32x4*)(C.state_shift + (size_t)b * SHIFT_W + ocol + 4);
                      pv[0] = s0.x; pv[1] = s0.y; pv[2] = s0.z; pv[3] = s0.w; pv[4] = s1.x; pv[5] = s1.y; pv[6] = s1.z; pv[7] = s1.w; }
                  const f32x4 m0 = *(const LAS f32x4*)(C.lds + L_MU + (arr * 64 + c8) * 4), m1 = *(const LAS f32x4*)(C.lds + L_MU + (arr * 64 + c8 + 4) * 4);
                  const float mu[8] = {m0.x, m0.y, m0.z, m0.w, m1.x, m1.y, m1.z, m1.w}; float xs[8];
#pragma unroll
                  for (int e = 0; e < 8; ++e) xs[e] = p[e] + mu[e] * (pv[e] - p[e]);
                  if (arr < 3) { LAS float* d = (arr == 0 ? sR : (arr == 1 ? sK : sV)) + tt * TS + c8;
                      *(LAS f32x4*)d = (f32x4){xs[0], xs[1], xs[2], xs[3]}; *(LAS f32x4*)(d + 4) = (f32x4){xs[4], xs[5], xs[6], xs[7]}; }
                  else { if (arr == 3) {
#pragma unroll
                          for (int e = 0; e < 8; ++e) xs[e] = fast_tanh(xs[e]); }
                      u32x4 w; w.x = pkbf(xs[0], xs[1]); w.y = pkbf(xs[2], xs[3]); w.z = pkbf(xs[4], xs[5]); w.w = pkbf(xs[6], xs[7]);
                      *(LAS u32x4*)((arr == 3 ? sTW : sAD) + tt * 72 + c8) = w; }
              } }
            if (ch + 1 < nchunk) SCAN_ISSUE(ch + 1);
            else if (it + C.G < 1280) { const int itn = it + C.G; const bool smp = itn >= 256; const int sn = smp ? itn - 256 : itn; const int nb = sn >> 5, nh = (sn >> 1) & 15;
                const size_t nrow0 = smp ? (size_t)NP_TOK + (size_t)nb * 64 : (size_t)nb * 2048; SCAN_ISSUE_AT(nrow0, nh, 0); }
            __syncthreads();
            { const int mat = wave >> 2, mt = wave & 3, fr = lane & 15, fq = lane >> 4;
              const LAS bf16_t* src = (mat ? sAD : sTW) + (16 * mt + fr) * 72 + 8 * fq;
              const bf16x8 a0f = *(const LAS bf16x8*)src, a1f = *(const LAS bf16x8*)(src + 32);
#pragma unroll
              for (int nt = 0; nt < 4; ++nt) {
                  const bf16x8 b0f = lw0[nt], b1f = lw1[nt];
                  f32x4 acc = (f32x4){0.f, 0.f, 0.f, 0.f};
                  acc = __builtin_amdgcn_mfma_f32_16x16x32_bf16(a0f, b0f, acc, 0, 0, 0);
                  acc = __builtin_amdgcn_mfma_f32_16x16x32_bf16(a1f, b1f, acc, 0, 0, 0);
                  const float bs = lbias[nt]; const int chn = 16 * nt + fr;
#pragma unroll
                  for (int j = 0; j < 4; ++j) { const int tok = 16 * mt + 4 * fq + j; const float pre_ = bs + acc[j]; float o;
                      if (mat == 0) o = __expf(-0.60653065971f * fast_sigmoid(pre_));
                      else o = fast_sigmoid(pre_);
                      (mat ? sB : sW)[tok * TS + chn] = o; } } }
            __syncthreads();
            { LAS float* sT = (LAS float*)(C.lds + L_T); float gacc = 1.f;
#pragma unroll
              for (int i8 = 0; i8 < 8; ++i8) { const int o = (8 * wave + i8) * TS + lane; gacc *= sW[o]; sW[o] = gacc; }
              sT[wave * 64 + lane] = gacc; }
            __syncthreads();
            { const int cq = lane & 15; const f32x4 kkc = *(const LAS f32x4*)(C.lds + L_KC + 16 * cq), kac = *(const LAS f32x4*)(C.lds + L_KC + 256 + 16 * cq), rkc = *(const LAS f32x4*)(C.lds + L_KC + 512 + 16 * cq);
              const LAS float* sT = (const LAS float*)(C.lds + L_T); f32x4 P = (f32x4){1.f, 1.f, 1.f, 1.f};
              for (int w2 = 0; w2 < wave; ++w2) P = P * *(const LAS f32x4*)(sT + w2 * 64 + 4 * cq);
              if (wave == 7 && lane < 16) *(LAS f32x4*)(C.lds + L_GT + 16 * cq) = P * *(const LAS f32x4*)(sT + 7 * 64 + 4 * cq);
#pragma unroll
              for (int i2 = 0; i2 < 2; ++i2) { const int tok = 8 * wave + 4 * i2 + (lane >> 4), o = tok * TS + 4 * cq;
                  const f32x4 ks = *(const LAS f32x4*)(sK + o), al = *(const LAS f32x4*)(sB + o), r = *(const LAS f32x4*)(sR + o); const f32x4 kkr = ks * kkc;
                  const f32x4 gt = *(const LAS f32x4*)(sW + o) * P; f32x4 gp = P; if (tok & 7) gp = *(const LAS f32x4*)(sW + o - TS) * P;
                  const float n2 = rowsum16((kkr.x * kkr.x + kkr.y * kkr.y) + (kkr.z * kkr.z + kkr.w * kkr.w)); const float inv = 1.f / fmaxf(sqrtf(n2), 1e-12f); const f32x4 kk = kkr * inv;
                  const f32x4 kp = ks * (1.f + (al - 1.f) * kac);
                  const f32x4 igt = (f32x4){__builtin_amdgcn_rcpf(gt.x), __builtin_amdgcn_rcpf(gt.y), __builtin_amdgcn_rcpf(gt.z), __builtin_amdgcn_rcpf(gt.w)};
                  *(LAS f32x4*)(sA + o) = -kk * gp; *(LAS f32x4*)(sB + o) = kk * al * igt; *(LAS f32x4*)(sK + o) = kp * igt; *(LAS f32x4*)(sR + o) = r * gt;
                  const f32x4 rk = r * kp * rkc; const float bon = rowsum16((rk.x + rk.y) + (rk.z + rk.w)); if (cq == 0) sBON[tok] = bon; } }
            __syncthreads();
            { const LAS float* pb = sR + 4 * jq; const LAS float* pv = sV + i; LAS float* pY = sY + il;
#define SCAN_LOAD(o, t) do { o.r = *(const LAS f32x4*)(pb + (t) * TS); o.k = *(const LAS f32x4*)(pb + (t) * TS + 64); \
                  o.a = *(const LAS f32x4*)(pb + (t) * TS + 256); o.b = *(const LAS f32x4*)(pb + (t) * TS + 320); o.v = pv[(t) * TS]; } while (0)
#define VMUL(d, x, y) asm("v_mul_f32 %0, %1, %2" : "=v"(d) : "v"(x), "v"(y))
#define VFMA(d, x, y, z) asm("v_fma_f32 %0, %1, %2, %3" : "=v"(d) : "v"(x), "v"(y), "v"(z))
              ScanOps cur, nx1; SCAN_LOAD(cur, 0); SCAN_LOAD(nx1, 1);
              const bool hi8 = (jq & 8) != 0, hi4 = (jq & 4) != 0; LAS float* pYq = sY + il + 32 * (((jq >> 2) & 1) * 2 + (jq >> 3));
#define SCAN_STEP(QV, TT) do { ScanOps nxt; const int tn = (TT) < 62 ? (TT) + 2 : 63; SCAN_LOAD(nxt, tn); \
                  float p; VMUL(p, s0, cur.a.x); VFMA(p, s1, cur.a.y, p); VFMA(p, s2, cur.a.z, p); VFMA(p, s3, cur.a.w, p); \
                  float u0, u1, u2, u3; \
                  VFMA(u0, cur.v, cur.k.x, s0); VFMA(u1, cur.v, cur.k.y, s1); VFMA(u2, cur.v, cur.k.z, s2); VFMA(u3, cur.v, cur.k.w, s3); \
                  const float sa = rowsum16(p); \
                  VFMA(s0, sa, cur.b.x, u0); VFMA(s1, sa, cur.b.y, u1); VFMA(s2, sa, cur.b.z, u2); VFMA(s3, sa, cur.b.w, u3); \
                  VMUL(QV, s0, cur.r.x); VFMA(QV, s1, cur.r.y, QV); VFMA(QV, s2, cur.r.z, QV); VFMA(QV, s3, cur.r.w, QV); \
                  cur = nx1; nx1 = nxt; } while (0)
#pragma unroll 1
              for (int t0 = 0; t0 < 64; t0 += 4) {
                  float q0, q1, q2, q3;
                  SCAN_STEP(q0, t0); SCAN_STEP(q1, t0 + 1); SCAN_STEP(q2, t0 + 2); SCAN_STEP(q3, t0 + 3);
                  float x01 = hi8 ? q1 : q0; const float y01 = hi8 ? q0 : q1; x01 += dpp_f<0x128>(y01);
                  float x23 = hi8 ? q3 : q2; const float y23 = hi8 ? q2 : q3; x23 += dpp_f<0x128>(y23);
                  float x = hi4 ? x23 : x01; const float yy = hi4 ? x01 : x23; x += dpp_f<0x141>(yy);
                  x += dpp_f<0xB1>(x); x += dpp_f<0x4E>(x);
                  pYq[t0 * 32] = x;
              }
              { const f32x4 gT = *(const LAS f32x4*)(C.lds + L_GT + 16 * jq); s0 *= gT.x; s1 *= gT.y; s2 *= gT.z; s3 *= gT.w; } }
#undef SCAN_STEP
            __syncthreads();
            { const int r4i = (tid & 7) * 4; const f32x4 y4 = *(const LAS f32x4*)(sY + tt * 32 + r4i);
              { u32x2 yw; yw.x = pkbf(y4.x, y4.y); yw.y = pkbf(y4.z, y4.w); *(u32x2*)(C.Yraw + (row0 + ch * 64 + tt) * 1024 + h * 64 + half * 32 + r4i) = yw; }
              if (half == 0 && tid < 64) C.bonus[(row0 + ch * 64 + tid) * 16 + h] = sBON[tid]; }
        }
        *(f32x4*)(C.out + (sample ? O_WKVS : O_WKVP) + ((size_t)(b * 16 + h) * 64 + i) * 64 + 4 * jq) = (f32x4){s0, s1, s2, s3};
        __syncthreads();
    }
#undef SCAN_ISSUE
#undef SCAN_ISSUE_AT
#undef SCAN_LOAD
#undef VMUL
#undef VFMA
}

constexpr int L_KS = 0, L_VT = 27648, L_OW = 53248;
__device__ __forceinline__ void load8(const Ctx& C, bool sample, bool isV, int b, int kvh, size_t qrow0, int key, int kmin, int c8, unsigned (&w)[4]) {
    if (key < kmin) { w[0] = w[1] = w[2] = w[3] = 0u; return; }
    if (sample && key < 128) { const float* src = (isV ? C.cache_v : C.cache_k) + ((size_t)(b * 128 + key) * 4 + kvh) * 64 + c8;
        const f32x4 s0 = *(const f32x4*)src, s1 = *(const f32x4*)(src + 4);
        w[0] = pkbf(s0.x, s0.y); w[1] = pkbf(s0.z, s0.w); w[2] = pkbf(s1.x, s1.y); w[3] = pkbf(s1.z, s1.w); return; }
    const u32x4 v = *(const u32x4*)(C.Z + (qrow0 + key - 128) * ZW + (isV ? ZVB : ZKB) + kvh * 64 + c8);
    w[0] = v.x; w[1] = v.y; w[2] = v.z; w[3] = v.w;
}
__device__ __forceinline__ void attn_item(const Ctx& C, int item) {
    const int tid = C.tid, lane = C.lane, wave = C.wave, fr = lane & 15, fq = lane >> 4;
    const bool sample = item >= 1024; int b, c, kvh;
    if (!sample) { b = item >> 7; c = (item >> 2) & 31; kvh = item & 3; } else { const int s = item - 1024; b = s >> 2; kvh = s & 3; c = 2; }
    const size_t qrow0 = sample ? (size_t)NP_TOK + (size_t)b * 64 : (size_t)b * 2048 + (size_t)c * 64;
    const int kmin = sample ? 0 : (c >= 2 ? 0 : 128 - c * 64);
    LAS bf16_t* Ks = (LAS bf16_t*)(C.lds + L_KS); LAS bf16_t* Vt = (LAS bf16_t*)(C.lds + L_VT);
    for (int p = tid; p < 1536; p += 512) {
        unsigned w[4];
        { const int key = p >> 3, c8 = (p & 7) * 8; load8(C, sample, false, b, kvh, qrow0, key, kmin, c8, w);
          *(LAS u32x4*)(Ks + key * 72 + c8) = (u32x4){w[0], w[1], w[2], w[3]}; }
        { const int key = p % 192, d0 = (p / 192) * 8; load8(C, sample, true, b, kvh, qrow0, key, kmin, d0, w);
#pragma unroll
          for (int e = 0; e < 4; ++e) { Vt[(d0 + 2 * e) * 200 + key] = (bf16_t)(w[e] & 0xffffu); Vt[(d0 + 2 * e + 1) * 200 + key] = (bf16_t)(w[e] >> 16); } }
    }
    __syncthreads();
    const int gq = wave >> 1, qh = wave & 1, hq = kvh * 4 + gq;
    const float slope = exp2f(-0.5f * (float)(hq + 1)), sink = C.sinks[hq];
#pragma unroll 1
    for (int nt = 0; nt < 2; ++nt) {
        bf16x8 qf[2];
#pragma unroll
        for (int ks = 0; ks < 2; ++ks) qf[ks] = *(const bf16x8*)(C.Z + (qrow0 + qh * 32 + nt * 16 + fr) * ZW + ZQ + hq * 64 + ks * 32 + 8 * fq);
        f32x4 sacc[12];
#pragma unroll
        for (int kt = 0; kt < 12; ++kt) sacc[kt] = (f32x4){0.f, 0.f, 0.f, 0.f};
#pragma unroll
        for (int kt = 0; kt < 12; ++kt)
#pragma unroll
            for (int ks = 0; ks < 2; ++ks) { const bf16x8 kf = *(const LAS bf16x8*)(Ks + (16 * kt + fr) * 72 + ks * 32 + 8 * fq);
                sacc[kt] = __builtin_amdgcn_mfma_f32_16x16x32_bf16(kf, qf[ks], sacc[kt], 0, 0, 0); }
        bf16x8 pf[6];
        { const float fd = (float)(qh * 32 + nt * 16 + fr + 128 - 4 * fq); float mx = -1e30f;
#pragma unroll
          for (int kt = 0; kt < 12; ++kt)
#pragma unroll
              for (int j = 0; j < 4; ++j) sacc[kt][j] = __builtin_fmaf(-slope, fabsf(fd - (float)(16 * kt + j)), sacc[kt][j]);
          if (kmin > 0) {
#pragma unroll
              for (int kt = 0; kt < 12; ++kt)
#pragma unroll
                  for (int j = 0; j < 4; ++j) { const int key = 16 * kt + 4 * fq + j; sacc[kt][j] = key >= kmin ? sacc[kt][j] : -1e30f; } }
#pragma unroll
          for (int kt = 0; kt < 12; ++kt)
#pragma unroll
              for (int j = 0; j < 4; ++j) mx = fmaxf(mx, sacc[kt][j]);
          mx = fmaxf(mx, __shfl_xor(mx, 16)); mx = fmaxf(mx, __shfl_xor(mx, 32)); mx = fmaxf(mx, sink);
          float sum = 0.f;
#pragma unroll
          for (int kt = 0; kt < 12; ++kt)
#pragma unroll
              for (int j = 0; j < 4; ++j) { const float e = __expf(sacc[kt][j] - mx); sacc[kt][j] = e; sum += e; }
          sum += __shfl_xor(sum, 16); sum += __shfl_xor(sum, 32);
          const float inv = 1.f / (sum + __expf(sink - mx));
#pragma unroll
          for (int kb = 0; kb < 6; ++kb) { const f32x4 e0 = sacc[2 * kb] * inv, e1 = sacc[2 * kb + 1] * inv;
              const u32x4 w = (u32x4){pkbf(e0[0], e0[1]), pkbf(e0[2], e0[3]), pkbf(e1[0], e1[1]), pkbf(e1[2], e1[3])}; pf[kb] = __builtin_bit_cast(bf16x8, w); }
        }
        f32x4 o[4];
#pragma unroll
        for (int nb = 0; nb < 4; ++nb) o[nb] = (f32x4){0.f, 0.f, 0.f, 0.f};
#pragma unroll
        for (int kb = 0; kb < 6; ++kb)
#pragma unroll
            for (int nb = 0; nb < 4; ++nb) { const LAS bf16_t* vp = Vt + (16 * nb + fr) * 200 + 32 * kb + 4 * fq;
                const u32x2 v0 = *(const LAS u32x2*)vp, v1 = *(const LAS u32x2*)(vp + 16);
                const bf16x8 vf = __builtin_bit_cast(bf16x8, ((u32x4){v0.x, v0.y, v1.x, v1.y}));
                o[nb] = __builtin_amdgcn_mfma_f32_16x16x32_bf16(pf[kb], vf, o[nb], 0, 0, 0); }
        { LAS float* Ow = (LAS float*)(C.lds + L_OW) + wave * (16 * 68);
#pragma unroll
          for (int nb = 0; nb < 4; ++nb)
#pragma unroll
              for (int j = 0; j < 4; ++j) Ow[(4 * fq + j) * 68 + 16 * nb + fr] = o[nb][j];
          const int qq = lane >> 2, dc = (lane & 3) * 16; const size_t tok = qrow0 + qh * 32 + 16 * nt + qq;
          const u32x4 g0 = *(const u32x4*)(C.Z + tok * ZW + ZGB + hq * 64 + dc), g1 = *(const u32x4*)(C.Z + tok * ZW + ZGB + hq * 64 + dc + 8);
          const LAS f32x4* orow = (const LAS f32x4*)(Ow + qq * 68 + dc); const f32x4 o0 = orow[0], o1 = orow[1], o2 = orow[2], o3 = orow[3];
          u32x4 w0, w1;
          w0.x = pkbf(o0.x * bflo(g0.x), o0.y * bfhi(g0.x)); w0.y = pkbf(o0.z * bflo(g0.y), o0.w * bfhi(g0.y)); w0.z = pkbf(o1.x * bflo(g0.z), o1.y * bfhi(g0.z)); w0.w = pkbf(o1.z * bflo(g0.w), o1.w * bfhi(g0.w));
          w1.x = pkbf(o2.x * bflo(g1.x), o2.y * bfhi(g1.x)); w1.y = pkbf(o2.z * bflo(g1.y), o2.w * bfhi(g1.y)); w1.z = pkbf(o3.x * bflo(g1.z), o3.y * bfhi(g1.z)); w1.w = pkbf(o3.z * bflo(g1.w), o3.w * bfhi(g1.w));
          bf16_t* yp = C.Ya + tok * 2048 + 1024 + hq * 64 + dc; *(u32x4*)yp = w0; *(u32x4*)(yp + 8) = w1; }
    }
    __syncthreads();
}
__device__ __forceinline__ void phase3(const Ctx& C) {
    for (int it = C.bid; it < 1152; it += C.G) attn_item(C, it);
    const int gw = C.bid * 8 + C.wave, NGW = C.G * 8, lane = C.lane;
    for (int wi0 = gw; wi0 < MTOK * 16 / 4; wi0 += 4 * NGW) {
        u32x2 yc[4]; f32x4 y4[4]; u32x2 vc[4], vp[4], gc[4]; float bon[4];
#pragma unroll
        for (int u = 0; u < 4; ++u) { const int wi = wi0 + u * NGW; if (wi < MTOK * 16 / 4) {
            const int pr = wi * 4 + (lane >> 4), tok = pr >> 4, h = pr & 15, col = h * 64 + 4 * (lane & 15); const bf16_t* zr = C.Z + (size_t)tok * ZW;
            yc[u] = __builtin_nontemporal_load((const u32x2*)(C.Yraw + (size_t)tok * 1024 + col)); vc[u] = *(const u32x2*)(zr + ZV + col); vp[u] = *(const u32x2*)(zr - (tok > 0 ? ZW : 0) + ZV + col);
            gc[u] = *(const u32x2*)(zr + ZGA + col); bon[u] = C.bonus[(size_t)tok * 16 + h]; } }
#pragma unroll
        for (int u = 0; u < 4; ++u) { const int wi = wi0 + u * NGW; if (wi < MTOK * 16 / 4) {
            const int pr = wi * 4 + (lane >> 4), tok = pr >> 4, h = pr & 15, col = h * 64 + 4 * (lane & 15);
            y4[u] = (f32x4){bflo(yc[u].x), bfhi(yc[u].x), bflo(yc[u].y), bfhi(yc[u].y)};
            const float mean = rowsum16((y4[u].x + y4[u].y) + (y4[u].z + y4[u].w)) * (1.f / 64.f); const f32x4 d = y4[u] - mean;
            const float var = rowsum16((d.x * d.x + d.y * d.y) + (d.z * d.z + d.w * d.w)) * (1.f / 64.f); const float rstd = rsqrtf(var + 64e-5f);
            const f32x4 v = (f32x4){bflo(vc[u].x), bfhi(vc[u].x), bflo(vc[u].y), bfhi(vc[u].y)}; f32x4 pv = (f32x4){bflo(vp[u].x), bfhi(vp[u].x), bflo(vp[u].y), bfhi(vp[u].y)};
            const int tin = tok < NP_TOK ? (tok & 2047) : ((tok - NP_TOK) & 63);
            if (tin == 0) { if (tok >= NP_TOK) pv = *(const f32x4*)(C.state_shift + (size_t)((tok - NP_TOK) >> 6) * SHIFT_W + 2048 + col); else pv = (f32x4){0.f, 0.f, 0.f, 0.f}; }
            const f32x4 mu4 = *(const f32x4*)(C.mu + 2048 + col); const f32x4 vs = v + mu4 * (pv - v);
            const f32x4 g4 = (f32x4){bflo(gc[u].x), bfhi(gc[u].x), bflo(gc[u].y), bfhi(gc[u].y)};
            const f32x4 lw = *(const f32x4*)(C.lnx_w + col), lb = *(const f32x4*)(C.lnx_b + col);
            const f32x4 o = (d * rstd * lw + lb + vs * bon[u]) * g4;
            u32x2 w; w.x = pkbf(o.x, o.y); w.y = pkbf(o.z, o.w); *(u32x2*)(C.Ya + (size_t)tok * 2048 + col) = w; } }
    }
}

__device__ __forceinline__ void phase6(const Ctx& C) {
    const int gw = C.bid * 8 + C.wave, NGW = C.G * 8;
    int m = gw; u32x4 v[4], vn[4];
    if (m >= MTOK) return;
    { const u32x4* xr = (const u32x4*)(C.out + (size_t)m * DM) + C.lane;
#pragma unroll
      for (int j = 0; j < 4; ++j) v[j] = xr[64 * j]; }
    for (;;) { const int mn = m + NGW; const bool more = mn < MTOK;
        if (more) { const u32x4* xn = (const u32x4*)(C.out + (size_t)mn * DM) + C.lane;
#pragma unroll
            for (int j = 0; j < 4; ++j) vn[j] = xn[64 * j]; }
        f32x4 f[4][2]; float s = 0.f;
#pragma unroll
        for (int j = 0; j < 4; ++j) { f[j][0] = (f32x4){bflo(v[j].x), bfhi(v[j].x), bflo(v[j].y), bfhi(v[j].y)}; f[j][1] = (f32x4){bflo(v[j].z), bfhi(v[j].z), bflo(v[j].w), bfhi(v[j].w)};
            s += (f[j][0].x * f[j][0].x + f[j][0].y * f[j][0].y) + (f[j][0].z * f[j][0].z + f[j][0].w * f[j][0].w) + (f[j][1].x * f[j][1].x + f[j][1].y * f[j][1].y) + (f[j][1].z * f[j][1].z + f[j][1].w * f[j][1].w); }
        const float rs = rsqrtf(wave_sum(s) * (1.f / DM) + 1e-6f);
        const f32x4* gr = (const f32x4*)C.g_final + 2 * C.lane; f32x4* orow = (f32x4*)(C.out + (size_t)m * DM) + 2 * C.lane;
#pragma unroll
        for (int j = 0; j < 4; ++j) { orow[128 * j] = f[j][0] * rs * gr[128 * j]; orow[128 * j + 1] = f[j][1] * rs * gr[128 * j + 1]; }
        if (!more) break;
#pragma unroll
        for (int j = 0; j < 4; ++j) v[j] = vn[j];
        m = mn; }
}

#define XB_TMO      128
#define XB_XCNT(j)  (256  + 64 * (j))
#define XB_XSUB(j)  (1280 + 64 * (j))
#define XB_XGEN(j)  (2304 + 64 * (j))
#define XB_TOP      3328
#define XB_TOPGEN   3392
#define XCD_BAR_WORDS 3456
#define XB_SPIN_CAP (1u << 18)

__device__ __forceinline__ unsigned xb_ld(unsigned* p)              { return __hip_atomic_load(p, __ATOMIC_RELAXED, __HIP_MEMORY_SCOPE_AGENT); }
__device__ __forceinline__ unsigned xb_add(unsigned* p, unsigned v) { return __hip_atomic_fetch_add(p, v, __ATOMIC_RELAXED, __HIP_MEMORY_SCOPE_AGENT); }
__device__ __forceinline__ unsigned xb_xcc_id() { return (unsigned)__builtin_amdgcn_s_getreg((3 << 11) | 20) & 0xFu; }
#define XB_SPIN(cond, bar) do { unsigned _sp = 0; while (cond) { __builtin_amdgcn_s_sleep(1); \
    if ((++_sp & 255u) == 0u) { if (xb_ld(&(bar)[XB_TMO])) break; if (_sp > XB_SPIN_CAP) { atomicAdd(&(bar)[XB_TMO], 1u); break; } } } } while (0)

struct XcdBarrier {
    unsigned* bar; unsigned x;
    volatile LAS unsigned* st;
};

__device__ __forceinline__ XcdBarrier xcd_barrier_post(unsigned* bar, volatile LAS unsigned* st) {
    XcdBarrier b; b.bar = bar; b.x = xb_xcc_id(); b.st = st;
    if (threadIdx.x == 0) (void)xb_add(&bar[XB_XCNT(b.x)], 1u);
    return b;
}
__device__ __forceinline__ void xcd_barrier_complete(unsigned* bar, unsigned x, unsigned& nloc, unsigned& nx) {
    const unsigned G = gridDim.x * gridDim.y * gridDim.z;
    unsigned sum, cnt, mine, sp = 0u;
    for (;;) {
        sum = 0u; cnt = 0u; mine = 0u;
#pragma unroll
        for (unsigned j = 0; j < 16; ++j) { const unsigned c = xb_ld(&bar[XB_XCNT(j)]); sum += c; cnt += (c > 0u) ? 1u : 0u; mine = (j == x) ? c : mine; }
        if (sum == G) break;
        __builtin_amdgcn_s_sleep(1);
        if ((++sp & 255u) == 0u) { if (xb_ld(&bar[XB_TMO])) break; if (sp > XB_SPIN_CAP) { atomicAdd(&bar[XB_TMO], 1u); break; } }
    }
    nloc = mine > 0u ? mine : 1u; nx = cnt > 0u ? cnt : 1u;
}

__device__ __forceinline__ void xcd_barrier(const XcdBarrier& b) {
    asm volatile("s_waitcnt vmcnt(0)" ::: "memory");
    __syncthreads();
    if (threadIdx.x == 0) {
        unsigned* bar = b.bar;
        __builtin_amdgcn_s_waitcnt(0);
        unsigned nloc = b.st[0], nx = b.st[1];
        if (nloc == 0u) { xcd_barrier_complete(bar, b.x, nloc, nx); b.st[0] = nloc; b.st[1] = nx; }
        const unsigned old = xb_add(&bar[XB_XSUB(b.x)], 1u);
        const unsigned gen = old / nloc;
        if (old + 1u == (gen + 1u) * nloc) {
            __builtin_amdgcn_fence(__ATOMIC_RELEASE, "agent");
            asm volatile("s_waitcnt vmcnt(0)" ::: "memory");
            const unsigned og = xb_add(&bar[XB_TOP], 1u);
            const unsigned tg = og / nx;
            if (og + 1u == (tg + 1u) * nx) xb_add(&bar[XB_TOPGEN], 1u);
            else XB_SPIN(xb_ld(&bar[XB_TOPGEN]) == tg, bar);
            __builtin_amdgcn_fence(__ATOMIC_ACQUIRE, "agent");
            xb_add(&bar[XB_XGEN(b.x)], 1u);
            asm volatile("s_waitcnt vmcnt(0)" ::: "memory");
        } else {
            XB_SPIN(xb_ld(&bar[XB_XGEN(b.x)]) == gen, bar);
            __builtin_amdgcn_fence(__ATOMIC_ACQUIRE, "agent");
            asm volatile("s_waitcnt vmcnt(0)" ::: "memory");
        }
    }
    __syncthreads();
}

__global__ void __launch_bounds__(512, 2) mega_fwd(Args a) {
    extern __shared__ __attribute__((aligned(16))) unsigned char lds_raw[];
    cg::grid_group grid = cg::this_grid();
    Ctx C;
    C.x_prompt = a.in[0]; C.x_sample = a.in[1]; C.state_wkv = a.in[2]; C.state_shift = a.in[3]; C.cache_k = a.in[4]; C.cache_v = a.in[5]; C.g_norm = a.in[6]; C.w_in = a.in[7];
    C.mu = a.in[8]; C.w0 = a.in[9]; C.w_w_up = a.in[10]; C.a0 = a.in[11]; C.w_a_up = a.in[12]; C.k_k = a.in[13]; C.k_a = a.in[14]; C.r_k = a.in[15]; C.lnx_w = a.in[16]; C.lnx_b = a.in[17];
    C.sinks = a.in[18]; C.p_a = a.in[19]; C.p_b = a.in[20]; C.w_o = a.in[21]; C.g_final = a.in[22];
    C.out = a.out; C.ws = a.ws;
    C.WinT = (bf16_t*)(a.ws + WS_WIN); C.PaT = (bf16_t*)(a.ws + WS_PA); C.PbT = (bf16_t*)(a.ws + WS_PB); C.WoT = (bf16_t*)(a.ws + WS_WO);
    C.WwT = (bf16_t*)(a.ws + WS_WW); C.WaT = (bf16_t*)(a.ws + WS_WA); C.bonus = (float*)(a.ws + WS_BON); C.Z = (bf16_t*)(a.ws + WS_Z);
    C.H = (bf16_t*)((unsigned char*)a.out + DO_H); C.Yraw = (bf16_t*)((unsigned char*)a.out + DO_YRAW); C.Ya = (bf16_t*)((unsigned char*)a.out + DO_YA); C.Yb = (bf16_t*)((unsigned char*)a.out + DO_YB);
    C.lds = (LAS unsigned char*)lds_raw;
    C.tid = threadIdx.x; C.lane = C.tid & 63; C.wave = __builtin_amdgcn_readfirstlane(C.tid >> 6); C.G = gridDim.x; C.bid = blockIdx.x;
    const int lo = a.ph_lo, hi = a.ph_hi;
    volatile LAS unsigned* misc = (volatile LAS unsigned*)(C.lds + L_MISC);
    if (C.tid < 2) misc[C.tid] = 0u;
    __syncthreads();
    XcdBarrier bar; bar.bar = (unsigned*)(a.ws + WS_BAR); bar.x = 0; bar.st = nullptr;
    if (hi - lo > 1) bar = xcd_barrier_post((unsigned*)(a.ws + WS_BAR), misc);
    if (lo > hi) grid.sync();
#define IN(k) (lo <= (k) && (k) < hi)
#define SEAM(k) do { if (IN(k) && IN((k) + 1)) xcd_barrier(bar); } while (0)
    if (IN(0)) phase0(C);
    SEAM(0);
    if (IN(1)) { pg8::Gemm g{C.H, C.WinT, MTOK, ZW, DM, DM}; pg8::StaticOrder S; S.init(MTOK, ZW, C.G, C.bid); EpiZ E{C.Z};
        pg8::gemm_phase<EpiZ, pg8::StaticOrder, true, true>(C.lds, g, S, E);
        { const int first = (72 * 43) % C.G, nidle = C.G - first; if (C.bid >= first) tr_run(C, (LAS float*)(C.lds + C.wave * 16384), (C.bid - first) * 8 + C.wave, nidle * 8, 1); } }
    SEAM(1);
    if (IN(2)) scan_phase(C);
    SEAM(2);
    if (IN(3)) phase3(C);
    SEAM(3);
    if (IN(4)) {
        { pg8::Gemm g{C.Ya, C.PaT, MTOK, DM, 2048, 2048}; pg8::StaticOrder S; S.init(MTOK, DM, C.G, C.bid); EpiMergeK E{C.Z};
          pg8::gemm_phase<EpiMergeK, pg8::StaticOrder, true, true>(C.lds, g, S, E); }
    }
    SEAM(4);
    if (IN(5)) { pg8::Gemm g{C.Z + ZMB, C.WoT, MTOK, DM, DM, ZW}; pg8::StaticOrder S; S.init(MTOK, DM, C.G, C.bid); EpiOut E{C.x_prompt, C.x_sample, C.out};
        pg8::gemm_phase<EpiOut, pg8::StaticOrder, true, true>(C.lds, g, S, E); }
    SEAM(5);
    if (IN(6)) phase6(C);
#undef IN
#undef SEAM
}

extern "C" void kernel_launch(void* const* d_in, const int* in_sizes, int n_in, void* d_out, int out_size, void* d_ws, size_t ws_size, hipStream_t stream) {
    static int grid = 0;
    if (grid == 0) {
        if (n_in != 23 || (size_t)out_size != O_END || ws_size < WS_END) { fprintf(stderr, "kernel_launch: unexpected sizes: n_in %d out %d ws %zu (need %zu)\n", n_in, out_size, ws_size, (size_t)WS_END); grid = -1; return; }
        int dev = 0, cus = 0, per_cu = 0;
        if (hipGetDevice(&dev) != hipSuccess || hipDeviceGetAttribute(&cus, hipDeviceAttributeMultiprocessorCount, dev) != hipSuccess) { grid = -1; return; }
        if (hipFuncSetAttribute((const void*)mega_fwd, hipFuncAttributeMaxDynamicSharedMemorySize, LDS_BYTES) != hipSuccess) { fprintf(stderr, "kernel_launch: hipFuncSetAttribute failed\n"); grid = -1; return; }
        if (hipOccupancyMaxActiveBlocksPerMultiprocessor(&per_cu, (const void*)mega_fwd, 512, LDS_BYTES) != hipSuccess || per_cu < 1) { fprintf(stderr, "kernel_launch: occupancy query failed (%d)\n", per_cu); (void)hipGetLastError(); grid = -1; return; }
        grid = cus * per_cu;
        fprintf(stderr, "kernel_launch: %d CUs x %d = grid %d\n", cus, per_cu, grid);
    }
    if (grid < 0) return;
    if (hipMemsetAsync((char*)d_ws + WS_BAR, 0, BAR_BYTES, stream) != hipSuccess) { fprintf(stderr, "kernel_launch: hipMemsetAsync failed\n"); return; }
    Args a{};
    for (int i = 0; i < 23; ++i) a.in[i] = (const float*)d_in[i];
    a.out = (float*)d_out; a.ws = (unsigned char*)d_ws;
#if MK_MULTI
    for (int k = 0; k < NPHASE; ++k) { a.ph_lo = k; a.ph_hi = k + 1; hipLaunchKernelGGL(mega_fwd, dim3(grid), dim3(512), LDS_BYTES, stream, a); }
#else
    a.ph_lo = 0; a.ph_hi = NPHASE;
    void* args[] = {&a};
    const hipError_t e = hipLaunchCooperativeKernel((const void*)mega_fwd, dim3(grid), dim3(512), args, LDS_BYTES, stream);
    if (e != hipSuccess) fprintf(stderr, "kernel_launch: cooperative launch failed: %s (grid %d)\n", hipGetErrorString(e), grid);
#endif
}
```

```cpp
#include <hip/hip_runtime.h>
#include <hip/hip_cooperative_groups.h>
#include <cstdio>
#include <cstdint>
namespace cg = cooperative_groups;

#ifndef MK_MULTI
#define MK_MULTI 0
#endif

namespace pg8 {
#define PG8_LAS __attribute__((address_space(3)))
typedef unsigned short bf16_t;
typedef short bf16x8 __attribute__((ext_vector_type(8)));
typedef float f32x4 __attribute__((ext_vector_type(4)));
typedef unsigned u32x4 __attribute__((ext_vector_type(4)));
constexpr int BM = 256, BK = 64, HALF = 128, HTB = HALF * BK * 2, STAGE_BYTES = 8 * HTB, NXCD = 8, WGM = 4;
__host__ __device__ __forceinline__ int lds_byte(int r, int c) { const int st = (r >> 4) * 2 + (c >> 5), rr = r & 15, cc = c & 31, ob = rr * 64 + cc * 2; return st * 1024 + (ob ^ (((ob >> 9) & 1) << 5)); }
__host__ __device__ __forceinline__ void stage_rc(int b, int& R, int& C) { const int st = b / 1024, sb = b % 1024, swz = sb ^ (((sb >> 9) & 1) << 5); R = (st >> 1) * 16 + swz / 64; C = (st & 1) * 32 + (swz % 64) / 2; }
__host__ __device__ __forceinline__ int perm32(int rho) { const int n = rho >> 4, i = rho & 15; return 8 * (i >> 2) + 4 * n + (i & 3); }
struct Unit { int pm, pn; };
struct Gemm { const bf16_t* A; const bf16_t* Bt; int M, N, K, lda; };
struct StaticOrder {
    int nM, nN, nwg, G, c;
    __host__ __device__ void init(int M, int N, int G_, int c_) { nM = M / BM; nN = N / BM; nwg = nM * nN; G = G_; c = c_; }
    __host__ __device__ bool next(int i, Unit& u) const {
        const long L = (long)i * G + c; if (L >= nwg) return false;
        int wgid = (int)L; { const int q = nwg / NXCD, r = nwg % NXCD, xcd = wgid % NXCD, off = wgid / NXCD; wgid = (xcd < r ? xcd * (q + 1) : r * (q + 1) + (xcd - r) * q) + off; }
        const int nig = WGM * nN, gid = wgid / nig, fm = gid * WGM, gsz = (nM - fm) < WGM ? (nM - fm) : WGM;
        u.pm = fm + ((wgid % nig) % gsz); u.pn = (wgid % nig) / gsz; return true;
    }
    __device__ __forceinline__ void a_ready(const Unit&) const {}
    __device__ __forceinline__ void done(const Unit&) const {}
};
__device__ __forceinline__ unsigned cvt_pk_bf16(float lo, float hi) { unsigned r; asm volatile("v_cvt_pk_bf16_f32 %0, %1, %2" : "=v"(r) : "v"(lo), "v"(hi)); return r; }
template <class Epi, class Sched, bool ALIGN_EPI = false, bool SP2 = false>
__device__ __forceinline__ void gemm_phase(PG8_LAS unsigned char* lds, const Gemm g, const Sched& S, const Epi& E) {
    const int tid = threadIdx.x, wid = __builtin_amdgcn_readfirstlane(tid >> 6), lane = tid & 63, wr = wid >> 2, wc = wid & 3, fr = lane & 15, fq = lane >> 4;
    const int K = g.K, nt = K / BK;
    unsigned voffA[2], voffB[2];
#pragma unroll
    for (int i = 0; i < 2; ++i) { int R, C; stage_rc(tid * 16 + i * 8192, R, C); const int Rb = Epi::PERM ? ((R & ~31) + perm32(R & 31)) : R;
        voffA[i] = (unsigned)(R * g.lda + C) * 2u; voffB[i] = (unsigned)(Rb * K + C) * 2u; }
    const size_t kstep = (size_t)(BK * 2);
    const size_t hstepB = (size_t)HALF * K * 2, hstepA = (size_t)HALF * g.lda * 2;
    const size_t tstepB = 2 * hstepB, tstepA = 2 * hstepA;
    const unsigned ldsw = (unsigned)wid * 1024u;
    const int aoff = lds_byte(wr * 64 + fr, fq * 8), boff = lds_byte(wc * 32 + fr, fq * 8);
#define PG8_SA(b, h) (((b) * 2 + (h)) * HTB)
#define PG8_SB(b, h) ((4 + (b) * 2 + (h)) * HTB)
#define PG8_STAGE(bufoff, gbase, voff) do { _Pragma("unroll") for (int _i = 0; _i < 2; ++_i) \
        __builtin_amdgcn_global_load_lds((const unsigned*)((const char*)(gbase) + (voff)[_i]), (PG8_LAS unsigned*)(lds + (bufoff) + ldsw + _i * 8192), 16, 0, 0); } while (0)
#define PG8_LDA(dst, b, h) do { _Pragma("unroll") for (int m = 0; m < 4; ++m) _Pragma("unroll") for (int k = 0; k < 2; ++k) dst[m][k] = *(const PG8_LAS bf16x8*)(lds + PG8_SA(b, h) + aoff + m * 2048 + k * 1024); } while (0)
#define PG8_LDB(dst, b, h) do { _Pragma("unroll") for (int n = 0; n < 2; ++n) _Pragma("unroll") for (int k = 0; k < 2; ++k) dst[n][k] = *(const PG8_LAS bf16x8*)(lds + PG8_SB(b, h) + boff + n * 2048 + k * 1024); } while (0)
#define PG8_MMA(ai, bj, At, Bt) do { __builtin_amdgcn_s_setprio(1); _Pragma("unroll") for (int m = 0; m < 4; ++m) _Pragma("unroll") for (int n = 0; n < 2; ++n) _Pragma("unroll") for (int k = 0; k < 2; ++k) \
        acc[ai][bj][m][n] = __builtin_amdgcn_mfma_f32_16x16x32_bf16(Bt[n][k], At[m][k], acc[ai][bj][m][n], 0, 0, 0); __builtin_amdgcn_s_setprio(0); } while (0)
#define PG8_WAIT_V(n) asm volatile("s_waitcnt vmcnt(" #n ")" ::: "memory")
#define PG8_WAIT_L(n) asm volatile("s_waitcnt lgkmcnt(" #n ")" ::: "memory")
#define PG8_BAR __builtin_amdgcn_s_barrier()
#define PG8_SCHED __builtin_amdgcn_sched_barrier(0)
    Unit cur, nxt; int ui = 0;
    if (!S.next(0, cur)) return;
    f32x4 acc[2][2][4][2];
#pragma unroll
    for (int a = 0; a < 2; ++a)
#pragma unroll
        for (int b = 0; b < 2; ++b)
#pragma unroll
            for (int m = 0; m < 4; ++m)
#pragma unroll
                for (int n = 0; n < 2; ++n) acc[a][b][m][n] = (f32x4){0.f, 0.f, 0.f, 0.f};
    bf16x8 At[4][2], B0[2][2], B1[2][2];
    const char* cA = (const char*)g.A + (size_t)cur.pm * tstepA; const char* cB = (const char*)g.Bt + (size_t)cur.pn * tstepB;
    S.a_ready(cur);
    if constexpr (SP2) {
        PG8_STAGE(PG8_SB(0, 0), cB, voffB); PG8_STAGE(PG8_SB(0, 1), cB + hstepB, voffB); PG8_STAGE(PG8_SA(0, 0), cA, voffA); PG8_STAGE(PG8_SA(0, 1), cA + hstepA, voffA);
        if (wr == 1) PG8_BAR;
        PG8_WAIT_V(2); PG8_BAR;
        PG8_STAGE(PG8_SB(1, 0), cB + kstep, voffB); PG8_STAGE(PG8_SA(1, 0), cA + kstep, voffA); PG8_STAGE(PG8_SB(1, 1), cB + hstepB + kstep, voffB);
        PG8_WAIT_V(6); PG8_BAR;
    } else {
        PG8_STAGE(PG8_SB(0, 0), cB, voffB); PG8_STAGE(PG8_SA(0, 0), cA, voffA); PG8_STAGE(PG8_SB(0, 1), cB + hstepB, voffB); PG8_STAGE(PG8_SA(0, 1), cA + hstepA, voffA);
        if (wr == 1) PG8_BAR;
        PG8_WAIT_V(4); PG8_BAR;
        PG8_STAGE(PG8_SB(1, 0), cB + kstep, voffB); PG8_STAGE(PG8_SA(1, 0), cA + kstep, voffA); PG8_STAGE(PG8_SB(1, 1), cB + hstepB + kstep, voffB);
        PG8_WAIT_V(6); PG8_BAR;
    }
    for (;;) {
        const bool has_next = S.next(ui + 1, nxt);
        const char* nA = has_next ? (const char*)g.A + (size_t)nxt.pm * tstepA : cA; const char* nB = has_next ? (const char*)g.Bt + (size_t)nxt.pn * tstepB : cB;
        for (int t = 0; t < nt; t += 2) {
            const bool last = (t == nt - 2);
            if constexpr (Epi::MIDHOOK) { if (t == nt / 2) { asm volatile("" ::: "memory"); __builtin_amdgcn_sched_barrier(0); E.mid(acc, cur, wr, wc, fr, fq); asm volatile("" ::: "memory"); __builtin_amdgcn_sched_barrier(0); } }
            const char* a1 = cA + (size_t)(t + 1) * kstep;
            const char* a2 = last ? nA : cA + (size_t)(t + 2) * kstep; const char* b2 = last ? nB : cB + (size_t)(t + 2) * kstep;
            const char* a3 = a2 + kstep; const char* b3 = b2 + kstep;
            if (last && has_next) S.a_ready(nxt);
            if constexpr (SP2) {
            PG8_LDB(B0, 0, 0); PG8_LDB(B1, 0, 1); PG8_SCHED; PG8_LDA(At, 0, 0); PG8_STAGE(PG8_SA(1, 1), a1 + hstepA, voffA);
            PG8_WAIT_V(8); PG8_WAIT_L(0); PG8_BAR; PG8_MMA(0, 0, At, B0); PG8_MMA(0, 1, At, B1); PG8_BAR; PG8_SCHED;
            PG8_LDA(At, 0, 1); PG8_STAGE(PG8_SB(0, 0), b2, voffB); PG8_STAGE(PG8_SB(0, 1), b2 + hstepB, voffB); PG8_STAGE(PG8_SA(0, 0), a2, voffA);
            PG8_WAIT_V(8); PG8_WAIT_L(0); PG8_BAR; PG8_MMA(1, 0, At, B0); PG8_MMA(1, 1, At, B1); PG8_BAR; PG8_SCHED;
            PG8_LDB(B0, 1, 0); PG8_LDB(B1, 1, 1); PG8_SCHED; PG8_LDA(At, 1, 0); PG8_STAGE(PG8_SA(0, 1), a2 + hstepA, voffA);
            PG8_WAIT_V(8); PG8_WAIT_L(0); PG8_BAR; PG8_MMA(0, 0, At, B0); PG8_MMA(0, 1, At, B1); PG8_BAR; PG8_SCHED;
            PG8_LDA(At, 1, 1); PG8_STAGE(PG8_SB(1, 0), b3, voffB); PG8_STAGE(PG8_SB(1, 1), b3 + hstepB, voffB); PG8_STAGE(PG8_SA(1, 0), a3, voffA);
            PG8_WAIT_V(8); PG8_WAIT_L(0); PG8_BAR; PG8_MMA(1, 0, At, B0); PG8_MMA(1, 1, At, B1); PG8_BAR; PG8_SCHED;
            } else {
            PG8_LDB(B0, 0, 0); PG8_SCHED; PG8_LDA(At, 0, 0); PG8_STAGE(PG8_SA(1, 1), a1 + hstepA, voffA);
            PG8_WAIT_L(8); PG8_BAR; PG8_WAIT_L(0); PG8_MMA(0, 0, At, B0); PG8_BAR; PG8_SCHED;
            PG8_LDB(B1, 0, 1); PG8_STAGE(PG8_SB(0, 0), b2, voffB);
            PG8_BAR; PG8_WAIT_L(0); PG8_MMA(0, 1, At, B1); PG8_BAR;
            PG8_LDA(At, 0, 1); PG8_STAGE(PG8_SA(0, 0), a2, voffA);
            PG8_BAR; PG8_WAIT_L(0); PG8_MMA(1, 0, At, B0); PG8_BAR; PG8_SCHED;
            PG8_STAGE(PG8_SB(0, 1), b2 + hstepB, voffB);
            PG8_WAIT_V(6); PG8_BAR; PG8_MMA(1, 1, At, B1); PG8_BAR;
            PG8_LDB(B0, 1, 0); PG8_SCHED; PG8_LDA(At, 1, 0); PG8_STAGE(PG8_SA(0, 1), a2 + hstepA, voffA);
            PG8_WAIT_L(8); PG8_BAR; PG8_WAIT_L(0); PG8_MMA(0, 0, At, B0); PG8_BAR; PG8_SCHED;
            PG8_LDB(B1, 1, 1); PG8_STAGE(PG8_SB(1, 0), b3, voffB);
            PG8_BAR; PG8_WAIT_L(0); PG8_MMA(0, 1, At, B1); PG8_BAR;
            PG8_LDA(At, 1, 1); PG8_STAGE(PG8_SA(1, 0), a3, voffA);
            PG8_BAR; PG8_WAIT_L(0); PG8_MMA(1, 0, At, B0); PG8_BAR; PG8_SCHED;
            PG8_STAGE(PG8_SB(1, 1), b3 + hstepB, voffB);
            PG8_WAIT_V(6); PG8_BAR; PG8_MMA(1, 1, At, B1); PG8_BAR;
            }
        }
        if constexpr (ALIGN_EPI) { if (wr == 0) PG8_BAR; }
        if constexpr (!Epi::AFTER_DRAIN) { E(acc, cur, wr, wc, fr, fq); S.done(cur); }
        if (!has_next) break;
#pragma unroll
        for (int a = 0; a < 2; ++a)
#pragma unroll
            for (int b = 0; b < 2; ++b)
#pragma unroll
                for (int m = 0; m < 4; ++m)
#pragma unroll
                    for (int n = 0; n < 2; ++n) acc[a][b][m][n] = (f32x4){0.f, 0.f, 0.f, 0.f};
        cur = nxt; cA = nA; cB = nB; ++ui;
        if constexpr (ALIGN_EPI) { if (wr == 1) PG8_BAR; }
    }
    PG8_WAIT_V(0);
    if constexpr (!ALIGN_EPI) { if (wr == 0) PG8_BAR; }
    PG8_BAR;
    if constexpr (Epi::AFTER_DRAIN) { E.fused(acc, cur, wr, wc, fr, fq, lds, wid, lane); S.done(cur); }
#undef PG8_SA
#undef PG8_SB
#undef PG8_STAGE
#undef PG8_LDA
#undef PG8_LDB
#undef PG8_MMA
#undef PG8_WAIT_V
#undef PG8_WAIT_L
#undef PG8_BAR
#undef PG8_SCHED
}
}

#define LAS __attribute__((address_space(3)))
typedef unsigned short bf16_t;
typedef short bf16x8 __attribute__((ext_vector_type(8)));
typedef float f32x4 __attribute__((ext_vector_type(4)));
typedef float f32x2 __attribute__((ext_vector_type(2)));
typedef unsigned u32x4 __attribute__((ext_vector_type(4)));
typedef unsigned u32x2 __attribute__((ext_vector_type(2)));

constexpr int DM = 2048, NP_TOK = 16384, MTOK = 18432, SHIFT_W = 3200;
constexpr int ZW = 11008;
constexpr int ZR = 0, ZK = 1024, ZV = 2048, ZGA = 3072, ZQ = 4096, ZKB = 5120, ZVB = 5376, ZGB = 5632, ZMA = 6656, ZMB = 8704, ZWD = 10752, ZAD = 10816;
constexpr size_t MiB = 1u << 20;
constexpr size_t WS_WIN = 0, WS_PA = 43 * MiB, WS_PB = 47 * MiB, WS_WO = 51 * MiB, WS_WW = 59 * MiB, WS_WA = 59 * MiB + 131072, WS_BON = 60 * MiB, WS_Z = 64 * MiB;
constexpr size_t WS_END = WS_Z + (size_t)MTOK * ZW * 2;
constexpr size_t WS_BAR = 63 * MiB, BAR_BYTES = 16384;
constexpr int L_MISC = 147200;
constexpr size_t DO_H = 0, DO_YRAW = 0, DO_YA = 72 * MiB, DO_YB = 108 * MiB;
constexpr size_t O_WKVP = 37748736, O_SHP = O_WKVP + 524288, O_KP = O_SHP + 25600, O_VP = O_KP + 262144, O_WKVS = O_VP + 262144, O_SHS = O_WKVS + 2097152, O_KS = O_SHS + 102400, O_VS = O_KS + 1048576, O_END = O_VS + 1048576;
constexpr int LDS_BYTES = 147456;
constexpr int NPHASE = 7;

struct Args { const float* in[23]; float* out; unsigned char* ws; int ph_lo, ph_hi; };

struct Ctx {
    const float *x_prompt, *x_sample, *state_wkv, *state_shift, *cache_k, *cache_v, *g_norm, *w_in, *mu, *w0, *w_w_up, *a0, *w_a_up, *k_k, *k_a, *r_k, *lnx_w, *lnx_b, *sinks, *p_a, *p_b, *w_o, *g_final;
    float* out; unsigned char* ws;
    bf16_t *WinT, *PaT, *PbT, *WoT, *WwT, *WaT, *Z, *H, *Ya, *Yb, *Yraw; float *bonus;
    LAS unsigned char* lds;
    int tid, lane, wave, G, bid;
};

__device__ __forceinline__ float bflo(unsigned u) { return __uint_as_float(u << 16); }
__device__ __forceinline__ float bfhi(unsigned u) { return __uint_as_float(u & 0xffff0000u); }
__device__ __forceinline__ float bf2f(bf16_t b) { return __uint_as_float((unsigned)b << 16); }
__device__ __forceinline__ unsigned pkbf(float lo, float hi) { return pg8::cvt_pk_bf16(lo, hi); }
__device__ __forceinline__ float wave_sum(float v) {
#pragma unroll
    for (int o = 1; o < 64; o <<= 1) v += __shfl_xor(v, o);
    return v;
}
template <int CTRL> __device__ __forceinline__ float dpp_f(float v) { return __builtin_bit_cast(float, __builtin_amdgcn_update_dpp(0, __builtin_bit_cast(int, v), CTRL, 0xF, 0xF, true)); }
__device__ __forceinline__ float rowsum16(float v) {
    v += dpp_f<0xB1>(v);
    v += dpp_f<0x4E>(v);
    v += dpp_f<0x141>(v);
    v += dpp_f<0x140>(v);
    return v;
}
__device__ __forceinline__ float fast_sigmoid(float x) { return __builtin_amdgcn_rcpf(1.f + __expf(-x)); }
__device__ __forceinline__ float fast_silu(float x) { return x * fast_sigmoid(x); }
__device__ __forceinline__ float fast_tanh(float x) { return 1.f - 2.f * __builtin_amdgcn_rcpf(1.f + __expf(2.f * x)); }
__device__ __forceinline__ const float* xrow(const Ctx& C, int m) { return m < NP_TOK ? C.x_prompt + (size_t)m * DM : C.x_sample + (size_t)(m - NP_TOK) * DM; }
#define LDS_WAIT() asm volatile("s_waitcnt lgkmcnt(0)" ::: "memory")

struct TrItem { const float* src; bf16_t* dst; int N, K; bool zero; };
__device__ __forceinline__ TrItem tr_item(const Ctx& C, int it) {
    constexpr int I_IN = 32 * 344, I_P = 16 * 64, I_O = 32 * 64, I_L = 32;
    TrItem t; int r = it; t.zero = false;
    if (r < I_IN) { const int kb = r / 344, nb = r % 344, zc = 32 * nb; const int src = zc < 3072 ? zc : (zc < 10752 ? zc + 128 : (zc < 10880 ? zc - 10752 + 3072 : -1));
        t.N = 10880; t.K = 2048; t.zero = src < 0; t.src = C.w_in + (size_t)(64 * kb) * 10880 + (src < 0 ? 0 : src); t.dst = C.WinT + (size_t)zc * 2048 + 64 * kb; return t; } r -= I_IN;
    if (r < I_P) { t.N = 2048; t.K = 2048; t.src = C.p_a + (size_t)(64 * (r / 64)) * 2048 + 32 * (r % 64); t.dst = C.PaT + (size_t)(32 * (r % 64)) * 2048 + 64 * (r / 64); return t; } r -= I_P;
    if (r < I_P) { t.N = 2048; t.K = 2048; t.src = C.p_b + (size_t)(64 * (r / 64)) * 2048 + 32 * (r % 64); t.dst = C.PaT + (size_t)(32 * (r % 64)) * 2048 + 1024 + 64 * (r / 64); return t; } r -= I_P;
    if (r < I_O) { t.N = 2048; t.K = 2048; t.src = C.w_o + (size_t)(64 * (r / 64)) * 2048 + 32 * (r % 64); t.dst = C.WoT + (size_t)(32 * (r % 64)) * 2048 + 64 * (r / 64); return t; } r -= I_O;
    if (r < I_L) { t.N = 1024; t.K = 64; t.src = C.w_w_up + 32 * r; t.dst = C.WwT + (size_t)(32 * r) * 64; return t; } r -= I_L;
    t.N = 1024; t.K = 64; t.src = C.w_a_up + 32 * r; t.dst = C.WaT + (size_t)(32 * r) * 64; return t;
}
__device__ __forceinline__ void tr_load(const TrItem& t, int lane, float (&v)[32]) {
#pragma unroll
    for (int i = 0; i < 32; ++i) v[i] = t.zero ? 0.f : __builtin_nontemporal_load(t.src + (size_t)(2 * i + (lane >> 5)) * t.N + (lane & 31));
}
__device__ __forceinline__ void tr_store(const TrItem& t, int lane, const float (&v)[32], LAS float* scr) {
#pragma unroll
    for (int i = 0; i < 32; ++i) scr[(2 * i + (lane >> 5)) * 33 + (lane & 31)] = v[i];
    LDS_WAIT(); asm volatile("" ::: "memory");
    const int c = lane & 7;
#pragma unroll
    for (int j = 0; j < 4; ++j) { const int n = (lane >> 3) + 8 * j; const LAS float* s = scr + (8 * c) * 33 + n;
        u32x4 o; o.x = pkbf(s[0 * 33], s[1 * 33]); o.y = pkbf(s[2 * 33], s[3 * 33]); o.z = pkbf(s[4 * 33], s[5 * 33]); o.w = pkbf(s[6 * 33], s[7 * 33]);
        *(u32x4*)(t.dst + (size_t)n * t.K + 8 * c) = o; }
    LDS_WAIT(); asm volatile("" ::: "memory");
}
__device__ __forceinline__ void tr_run(const Ctx& C, LAS float* scr, int w0, int nw, int set) {
    constexpr int I_IN = 32 * 344, I_MID = 2 * 16 * 64 + 32 * 64, I_L = 2 * 32;
    const int n = set == 0 ? I_IN + I_L : I_MID;
    float va[32], vb[32]; int it = w0;
    if (it >= n) return;
#define TR_ID(i) (set == 0 ? ((i) < I_IN ? (i) : (i) + I_MID) : (i) + I_IN)
    TrItem ta = tr_item(C, TR_ID(it)); tr_load(ta, C.lane, va);
    for (;;) { const int itn = it + nw; const bool more = itn < n; TrItem tb = ta;
        if (more) { tb = tr_item(C, TR_ID(itn)); tr_load(tb, C.lane, vb); }
        tr_store(ta, C.lane, va, scr);
        if (!more) break;
#pragma unroll
        for (int i = 0; i < 32; ++i) va[i] = vb[i];
        ta = tb; it = itn; }
#undef TR_ID
}
__device__ __forceinline__ void phase0(const Ctx& C) {
    LAS float* scr = (LAS float*)(C.lds + C.wave * 16384);
    const int gw = C.bid * 8 + C.wave, NGW = C.G * 8;
    tr_run(C, scr, gw, NGW, 0);
    {
      int m = gw; f32x4 v[8], vn[8];
      if (m < MTOK) { const f32x4* xr = (const f32x4*)xrow(C, m) + C.lane;
#pragma unroll
          for (int j = 0; j < 8; ++j) v[j] = __builtin_nontemporal_load(xr + 64 * j);
          for (;;) { const int mn = m + NGW; const bool more = mn < MTOK;
              if (more) { const f32x4* xn = (const f32x4*)xrow(C, mn) + C.lane;
#pragma unroll
                  for (int j = 0; j < 8; ++j) vn[j] = __builtin_nontemporal_load(xn + 64 * j); }
              float s = 0.f;
#pragma unroll
              for (int j = 0; j < 8; ++j) s += (v[j].x * v[j].x + v[j].y * v[j].y) + (v[j].z * v[j].z + v[j].w * v[j].w);
              const float rs = rsqrtf(wave_sum(s) * (1.f / DM) + 1e-6f);
              u32x2* o8 = (u32x2*)(C.H + (size_t)m * DM) + C.lane; const f32x4* gr = (const f32x4*)C.g_norm + C.lane;
#pragma unroll
              for (int j = 0; j < 8; ++j) { const f32x4 g = gr[64 * j]; u32x2 w; w.x = pkbf(v[j].x * rs * g.x, v[j].y * rs * g.y); w.y = pkbf(v[j].z * rs * g.z, v[j].w * rs * g.w); o8[64 * j] = w; }
              if (!more) break;
#pragma unroll
              for (int j = 0; j < 8; ++j) v[j] = vn[j];
              m = mn; } } }
}

struct EpiZ {
    static constexpr bool PERM = true, AFTER_DRAIN = false, MIDHOOK = false;
    bf16_t* Z;
    __device__ __forceinline__ void operator()(const f32x4 (&acc)[2][2][4][2], const pg8::Unit& u, int wr, int wc, int fr, int fq) const {
        const int pn = u.pn; const int act = (pn >= 12 && pn < 16) || (pn >= 22 && pn < 26) ? 1 : ((pn >= 26 && pn < 42) ? 2 : ((pn >= 16 && pn < 20) ? 3 : 0));
        const int row0 = u.pm * 256 + wr * 64 + fr, col0 = pn * 256 + wc * 32 + 8 * fq;
#pragma unroll
        for (int ai = 0; ai < 2; ++ai)
#pragma unroll
            for (int m = 0; m < 4; ++m) { bf16_t* rowp = Z + (unsigned)((row0 + ai * 128 + m * 16) * ZW + col0);
#pragma unroll
                for (int bj = 0; bj < 2; ++bj) { f32x4 v0 = acc[ai][bj][m][0], v1 = acc[ai][bj][m][1];
                    if (act == 1) {
#pragma unroll
                        for (int e = 0; e < 4; ++e) { v0[e] = fast_silu(v0[e]); v1[e] = fast_silu(v1[e]); } }
                    else if (act == 2) {
#pragma unroll
                        for (int e = 0; e < 4; ++e) { v0[e] = fast_sigmoid(v0[e]); v1[e] = fast_sigmoid(v1[e]); } }
                    else if (act == 3) { v0 = v0 * 0.125f; v1 = v1 * 0.125f; }
                    if (act == 2) {
                        unsigned lo = 0u, hi = 0u;
                        lo = __builtin_amdgcn_cvt_pk_u8_f32(__builtin_rintf(v0[0] * 255.f), 0, lo); lo = __builtin_amdgcn_cvt_pk_u8_f32(__builtin_rintf(v0[1] * 255.f), 1, lo); lo = __builtin_amdgcn_cvt_pk_u8_f32(__builtin_rintf(v0[2] * 255.f), 2, lo); lo = __builtin_amdgcn_cvt_pk_u8_f32(__builtin_rintf(v0[3] * 255.f), 3, lo);
                        hi = __builtin_amdgcn_cvt_pk_u8_f32(__builtin_rintf(v1[0] * 255.f), 0, hi); hi = __builtin_amdgcn_cvt_pk_u8_f32(__builtin_rintf(v1[1] * 255.f), 1, hi); hi = __builtin_amdgcn_cvt_pk_u8_f32(__builtin_rintf(v1[2] * 255.f), 2, hi); hi = __builtin_amdgcn_cvt_pk_u8_f32(__builtin_rintf(v1[3] * 255.f), 3, hi);
                        unsigned char* gb = (unsigned char*)Z + ((unsigned)((row0 + ai * 128 + m * 16) * ZW + ZMA) * 2u + (unsigned)((pn >= 34 ? 2048 + (pn - 34) * 256 : (pn - 26) * 256) + wc * 32 + 8 * fq + bj * 128));
                        *(u32x2*)gb = (u32x2){lo, hi};
                    } else {
                    u32x4 w; w.x = pkbf(v0[0], v0[1]); w.y = pkbf(v0[2], v0[3]); w.z = pkbf(v1[0], v1[1]); w.w = pkbf(v1[2], v1[3]);
                    *(u32x4*)(rowp + bj * 128) = w; } } }
    }
};
template <int PASS> struct EpiMerge {
    static constexpr bool PERM = true, AFTER_DRAIN = false, MIDHOOK = false;
    bf16_t* Z;
    __device__ __forceinline__ void operator()(const f32x4 (&acc)[2][2][4][2], const pg8::Unit& u, int wr, int wc, int fr, int fq) const {
        const int row0 = u.pm * 256 + wr * 64 + fr, col0 = u.pn * 256 + wc * 32 + 8 * fq;
#pragma unroll
        for (int ai = 0; ai < 2; ++ai)
#pragma unroll
            for (int m = 0; m < 4; ++m) { bf16_t* rowz = Z + (size_t)(row0 + ai * 128 + m * 16) * ZW; const unsigned char* gb = (const unsigned char*)(rowz + ZMA) + (PASS ? 2048 : 0) + col0; bf16_t* rowp = rowz + ZMB + col0;
#pragma unroll
                for (int bj = 0; bj < 2; ++bj) { const f32x4 v0 = acc[ai][bj][m][0], v1 = acc[ai][bj][m][1];
                    const u32x2 g8 = __builtin_nontemporal_load((const u32x2*)(gb + bj * 128)); const float k = 1.f / 255.f; float r[8];
                    const float g0 = (float)((g8.x >> 0) & 0xffu) * k, g1 = (float)((g8.x >> 8) & 0xffu) * k, g2 = (float)((g8.x >> 16) & 0xffu) * k, g3 = (float)((g8.x >> 24) & 0xffu) * k;
                    const float g4 = (float)((g8.y >> 0) & 0xffu) * k, g5 = (float)((g8.y >> 8) & 0xffu) * k, g6 = (float)((g8.y >> 16) & 0xffu) * k, g7 = (float)((g8.y >> 24) & 0xffu) * k;
                    if (PASS == 0) {
                        r[0] = g0 * v0[0]; r[1] = g1 * v0[1]; r[2] = g2 * v0[2]; r[3] = g3 * v0[3]; r[4] = g4 * v1[0]; r[5] = g5 * v1[1]; r[6] = g6 * v1[2]; r[7] = g7 * v1[3];
                    } else {
                        const u32x4 t = *(const u32x4*)(rowp + bj * 128);
                        r[0] = bflo(t.x) + g0 * v0[0]; r[1] = bfhi(t.x) + g1 * v0[1]; r[2] = bflo(t.y) + g2 * v0[2]; r[3] = bfhi(t.y) + g3 * v0[3];
                        r[4] = bflo(t.z) + g4 * v1[0]; r[5] = bfhi(t.z) + g5 * v1[1]; r[6] = bflo(t.w) + g6 * v1[2]; r[7] = bfhi(t.w) + g7 * v1[3];
                    }
                    u32x4 w; w.x = pkbf(r[0], r[1]); w.y = pkbf(r[2], r[3]); w.z = pkbf(r[4], r[5]); w.w = pkbf(r[6], r[7]);
                    *(u32x4*)(rowp + bj * 128) = w; } }
    }
};
struct EpiMergeK {
    static constexpr bool PERM = true, AFTER_DRAIN = false, MIDHOOK = true;
    bf16_t* Z;
    __device__ __forceinline__ void mid(f32x4 (&acc)[2][2][4][2], const pg8::Unit& u, int wr, int wc, int fr, int fq) const {
        unsigned off = (unsigned)((u.pm * 256 + wr * 64 + fr) * ZW + ZMA) * 2u + (unsigned)(u.pn * 256 + wc * 32 + 8 * fq);
        const unsigned char* zb = (const unsigned char*)Z;
#pragma unroll
        for (int ai = 0; ai < 2; ++ai)
#pragma unroll
            for (int m = 0; m < 4; ++m) {
#pragma unroll
                for (int bj = 0; bj < 2; ++bj) { asm volatile("" : "+v"(off));
                    const unsigned o2 = off + (unsigned)((ai * 128 + m * 16) * ZW * 2 + bj * 128);
                    const u32x2 a8 = __builtin_nontemporal_load((const u32x2*)(zb + o2)), b8 = *(const u32x2*)(zb + o2 + 2048);
#pragma unroll
                    for (int e = 0; e < 4; ++e) { const float ga0 = (float)((a8.x >> (8 * e)) & 0xffu), gb0 = fmaxf((float)((b8.x >> (8 * e)) & 0xffu), 1.f), ga1 = (float)((a8.y >> (8 * e)) & 0xffu), gb1 = fmaxf((float)((b8.y >> (8 * e)) & 0xffu), 1.f);
                        acc[ai][bj][m][0][e] *= ga0 * __builtin_amdgcn_rcpf(gb0); acc[ai][bj][m][1][e] *= ga1 * __builtin_amdgcn_rcpf(gb1); }
                    asm volatile("" ::: "memory"); } }
    }
    __device__ __forceinline__ void operator()(const f32x4 (&acc)[2][2][4][2], const pg8::Unit& u, int wr, int wc, int fr, int fq) const {
        const int row0 = u.pm * 256 + wr * 64 + fr, col0 = u.pn * 256 + wc * 32 + 8 * fq;
#pragma unroll
        for (int ai = 0; ai < 2; ++ai)
#pragma unroll
            for (int m = 0; m < 4; ++m) { bf16_t* rowz = Z + (size_t)(row0 + ai * 128 + m * 16) * ZW; const unsigned char* gb = (const unsigned char*)(rowz + ZMA) + 2048 + col0; bf16_t* rowp = rowz + ZMB + col0;
#pragma unroll
                for (int bj = 0; bj < 2; ++bj) { const f32x4 v0 = acc[ai][bj][m][0], v1 = acc[ai][bj][m][1]; const u32x2 b8 = *(const u32x2*)(gb + bj * 128); const float k = 1.f / 255.f; float r[8];
#pragma unroll
                    for (int e = 0; e < 4; ++e) { r[e] = v0[e] * (fmaxf((float)((b8.x >> (8 * e)) & 0xffu), 1.f) * k); r[4 + e] = v1[e] * (fmaxf((float)((b8.y >> (8 * e)) & 0xffu), 1.f) * k); }
                    u32x4 w; w.x = pkbf(r[0], r[1]); w.y = pkbf(r[2], r[3]); w.z = pkbf(r[4], r[5]); w.w = pkbf(r[6], r[7]);
                    *(u32x4*)(rowp + bj * 128) = w; } }
    }
};
struct EpiOut {
    static constexpr bool PERM = true, AFTER_DRAIN = false, MIDHOOK = false;
    const float* xp; const float* xs; float* out;
    __device__ __forceinline__ void operator()(const f32x4 (&acc)[2][2][4][2], const pg8::Unit& u, int wr, int wc, int fr, int fq) const {
        const int row0 = u.pm * 256 + wr * 64 + fr, col0 = u.pn * 256 + wc * 32 + 8 * fq;
        const float* xb = u.pm < NP_TOK / 256 ? xp : xs - (size_t)NP_TOK * DM;
#pragma unroll
        for (int ai = 0; ai < 2; ++ai)
#pragma unroll
            for (int m = 0; m < 4; ++m) { const int row = row0 + ai * 128 + m * 16;
                const float* xr = xb + (unsigned)(row * DM + col0); bf16_t* orow = (bf16_t*)out + (unsigned)(row * DM * 2 + col0);
#pragma unroll
                for (int bj = 0; bj < 2; ++bj) { const f32x4 v0 = __builtin_nontemporal_load((const f32x4*)(xr + bj * 128)) + acc[ai][bj][m][0], v1 = __builtin_nontemporal_load((const f32x4*)(xr + bj * 128 + 4)) + acc[ai][bj][m][1];
                    u32x4 w; w.x = pkbf(v0[0], v0[1]); w.y = pkbf(v0[2], v0[3]); w.z = pkbf(v1[0], v1[1]); w.w = pkbf(v1[2], v1[3]);
                    *(u32x4*)(orow + bj * 128) = w; } }
    }
};

constexpr int L_MU = 125184, L_KC = 126464, L_T = 127232, L_GT = 129280;
constexpr int TS = 384;
constexpr int L_R = 0, L_K = 256, L_V = 512, L_W = 768, L_A = 1024, L_B = 1280, L_TW = 98304, L_AD = 107520, L_Y = 116736, L_BON = 124928;
struct ScanOps { f32x4 a, b, k, r; float v; };
__device__ __forceinline__ void swap16(float& a, float& b) { asm("s_nop 1\n\tv_permlane16_swap_b32 %0, %1" : "+v"(a), "+v"(b)); }
__device__ __forceinline__ float swap16_sum_rows(f32x2 p) {
    float x = p.x, y = p.y; swap16(x, y);
    return rowsum16(x + y);
}
__device__ __forceinline__ f32x2 swap16_sum_bcast(f32x2 p) {
    const float s = swap16_sum_rows(p);
    float x = s, y = s; swap16(x, y);
    return (f32x2){x, y};
}
__device__ __forceinline__ void copy_outputs(const Ctx& C) {
    const int gt = C.bid * 512 + C.tid, NGT = C.G * 512;
    for (int e = gt; e < 8 * SHIFT_W; e += NGT) { const int b = e / SHIFT_W, c = e % SHIFT_W; C.out[O_SHP + e] = bf2f(C.Z[((size_t)b * 2048 + 2047) * ZW + (c < 3072 ? c : ZWD + c - 3072)]); }
    for (int e = gt; e < 32 * SHIFT_W; e += NGT) { const int b = e / SHIFT_W, c = e % SHIFT_W; C.out[O_SHS + e] = bf2f(C.Z[((size_t)NP_TOK + b * 64 + 63) * ZW + (c < 3072 ? c : ZWD + c - 3072)]); }
    for (int e4 = gt; e4 < 8 * 128 * 64; e4 += NGT) { const int e = e4 * 4, b = e >> 15, j = (e >> 8) & 127, c = e & 255; const bf16_t* zr = C.Z + ((size_t)b * 2048 + 1920 + j) * ZW;
        const u32x2 k2 = *(const u32x2*)(zr + ZKB + c), v2 = *(const u32x2*)(zr + ZVB + c);
        *(f32x4*)(C.out + O_KP + e) = (f32x4){bflo(k2.x), bfhi(k2.x), bflo(k2.y), bfhi(k2.y)}; *(f32x4*)(C.out + O_VP + e) = (f32x4){bflo(v2.x), bfhi(v2.x), bflo(v2.y), bfhi(v2.y)}; }
    for (int e4 = gt; e4 < 32 * 128 * 64; e4 += NGT) { const int e = e4 * 4, b = e >> 15, j = (e >> 8) & 127, c = e & 255;
        if (j < 64) { *(f32x4*)(C.out + O_KS + e) = *(const f32x4*)(C.cache_k + ((size_t)b * 128 + 64 + j) * 256 + c); *(f32x4*)(C.out + O_VS + e) = *(const f32x4*)(C.cache_v + ((size_t)b * 128 + 64 + j) * 256 + c); }
        else { const bf16_t* zr = C.Z + ((size_t)NP_TOK + b * 64 + (j - 64)) * ZW; const u32x2 k2 = *(const u32x2*)(zr + ZKB + c), v2 = *(const u32x2*)(zr + ZVB + c);
            *(f32x4*)(C.out + O_KS + e) = (f32x4){bflo(k2.x), bfhi(k2.x), bflo(k2.y), bfhi(k2.y)}; *(f32x4*)(C.out + O_VS + e) = (f32x4){bflo(v2.x), bfhi(v2.x), bflo(v2.y), bfhi(v2.y)}; } }
}
struct ScanPre { u32x4 cu[5]; u32x4 pu[5]; };
__device__ __forceinline__ void scan_phase(const Ctx& C) {
    const int tid = C.tid, lane = C.lane, wave = C.wave;
    copy_outputs(C);
    LAS float* sR = (LAS float*)(C.lds + L_R); LAS float* sK = (LAS float*)(C.lds + L_K); LAS float* sV = (LAS float*)(C.lds + L_V);
    LAS float* sW = (LAS float*)(C.lds + L_W); LAS float* sA = (LAS float*)(C.lds + L_A); LAS float* sB = (LAS float*)(C.lds + L_B);
    LAS bf16_t* sTW = (LAS bf16_t*)(C.lds + L_TW); LAS bf16_t* sAD = (LAS bf16_t*)(C.lds + L_AD);
    LAS float* sY = (LAS float*)(C.lds + L_Y); LAS float* sBON = (LAS float*)(C.lds + L_BON);
    for (int it = C.bid; it < 1280; it += C.G) {
        const bool sample = it >= 256; const int s_ = sample ? it - 256 : it;
        const int b = s_ >> 5, h = (s_ >> 1) & 15, half = s_ & 1;
        const int nchunk = sample ? 1 : 32; const size_t row0 = sample ? (size_t)NP_TOK + (size_t)b * 64 : (size_t)b * 2048;
        const int g = lane >> 4, jq = lane & 15, il = 4 * wave + g, i = half * 32 + il;
        float s0 = 0.f, s1 = 0.f, s2 = 0.f, s3 = 0.f;
        if (sample) { const f32x4 r0 = *(const f32x4*)(C.state_wkv + ((size_t)(b * 16 + h) * 64 + i) * 64 + 4 * jq); s0 = r0.x; s1 = r0.y; s2 = r0.z; s3 = r0.w; }
        const int tt = tid >> 3, c8 = (tid & 7) * 8;
        ScanPre pre;
        { LAS float* smu = (LAS float*)(C.lds + L_MU); LAS float* skc = (LAS float*)(C.lds + L_KC);
          if (tid < 320) { const int arr = tid >> 6, c = tid & 63; smu[tid] = C.mu[arr < 3 ? arr * 1024 + h * 64 + c : (arr == 3 ? 3072 + c : 3136 + c)]; }
          else if (tid < 384) skc[tid - 320] = C.k_k[h * 64 + (tid - 320)];
          else if (tid < 448) skc[tid - 320] = C.k_a[h * 64 + (tid - 384)];
          else skc[tid - 320] = C.r_k[h * 64 + (tid - 448)]; }
        const int mat_ = wave >> 2, fr_ = lane & 15, fq_ = lane >> 4;
        bf16x8 lw0[4], lw1[4]; float lbias[4];
        { const bf16_t* wt = (mat_ ? C.WaT : C.WwT) + (size_t)(h * 64 + fr_) * 64 + 8 * fq_; const float* bias = (mat_ ? C.a0 : C.w0) + h * 64 + fr_;
#pragma unroll
          for (int nt = 0; nt < 4; ++nt) { lw0[nt] = *(const bf16x8*)(wt + nt * 16 * 64); lw1[nt] = *(const bf16x8*)(wt + nt * 16 * 64 + 32); lbias[nt] = bias[nt * 16]; } }
#define SCAN_ISSUE_AT(ROW0, HH, CH) do { const int t_ = (CH) * 64 + tt; const bf16_t* zr_ = C.Z + ((ROW0) + t_) * ZW; \
            _Pragma("unroll") for (int arr = 0; arr < 5; ++arr) { const int zcol = arr < 3 ? arr * 1024 + (HH) * 64 + c8 : (arr == 3 ? ZWD + c8 : ZAD + c8); \
                pre.cu[arr] = *(const u32x4*)(zr_ + zcol); pre.pu[arr] = t_ > 0 ? *(const u32x4*)(zr_ - ZW + zcol) : (u32x4){0u, 0u, 0u, 0u}; } } while (0)
#define SCAN_ISSUE(CH) SCAN_ISSUE_AT(row0, h, CH)
        if (it == C.bid) SCAN_ISSUE(0);
        __syncthreads();
        for (int ch = 0; ch < nchunk; ++ch) {
            { const int t = ch * 64 + tt;
#pragma unroll
              for (int arr = 0; arr < 5; ++arr) {
                  const int zcol = arr < 3 ? arr * 1024 + h * 64 + c8 : (arr == 3 ? ZWD + c8 : ZAD + c8);
                  const int ocol = arr < 3 ? zcol : (arr == 3 ? 3072 + c8 : 3136 + c8);
                  const u32x4 cu = pre.cu[arr], pu = pre.pu[arr]; float p[8], pv[8];
                  p[0] = bflo(cu.x); p[1] = bfhi(cu.x); p[2] = bflo(cu.y); p[3] = bfhi(cu.y); p[4] = bflo(cu.z); p[5] = bfhi(cu.z); p[6] = bflo(cu.w); p[7] = bfhi(cu.w);
                  pv[0] = bflo(pu.x); pv[1] = bfhi(pu.x); pv[2] = bflo(pu.y); pv[3] = bfhi(pu.y); pv[4] = bflo(pu.z); pv[5] = bfhi(pu.z); pv[6] = bflo(pu.w); pv[7] = bfhi(pu.w);
                  if (t == 0 && sample) { const f32x4 s0 = *(const f32x4*)(C.state_shift + (size_t)b * SHIFT_W + ocol), s1 = *(const f32x4*)(C.state_shift + (size_t)b * SHIFT_W + ocol + 4);
                      pv[0] = s0.x; pv[1] = s0.y; pv[2] = s0.z; pv[3] = s0.w; pv[4] = s1.x; pv[5] = s1.y; pv[6] = s1.z; pv[7] = s1.w; }
                  const f32x4 m0 = *(const LAS f32x4*)(C.lds + L_MU + (arr * 64 + c8) * 4), m1 = *(const LAS f32x4*)(C.lds + L_MU + (arr * 64 + c8 + 4) * 4);
                  const float mu[8] = {m0.x, m0.y, m0.z, m0.w, m1.x, m1.y, m1.z, m1.w}; float xs[8];
#pragma unroll
                  for (int e = 0; e < 8; ++e) xs[e] = p[e] + mu[e] * (pv[e] - p[e]);
                  if (arr < 3) { LAS float* d = (arr == 0 ? sR : (arr == 1 ? sK : sV)) + tt * TS + c8;
                      *(LAS f32x4*)d = (f32x4){xs[0], xs[1], xs[2], xs[3]}; *(LAS f32x4*)(d + 4) = (f32x4){xs[4], xs[5], xs[6], xs[7]}; }
                  else { if (arr == 3) {
#pragma unroll
                          for (int e = 0; e < 8; ++e) xs[e] = fast_tanh(xs[e]); }
                      u32x4 w; w.x = pkbf(xs[0], xs[1]); w.y = pkbf(xs[2], xs[3]); w.z = pkbf(xs[4], xs[5]); w.w = pkbf(xs[6], xs[7]);
                      *(LAS u32x4*)((arr == 3 ? sTW : sAD) + tt * 72 + c8) = w; }
              } }
            if (ch + 1 < nchunk) SCAN_ISSUE(ch + 1);
            else if (it + C.G < 1280) { const int itn = it + C.G; const bool smp = itn >= 256; const int sn = smp ? itn - 256 : itn; const int nb = sn >> 5, nh = (sn >> 1) & 15;
                const size_t nrow0 = smp ? (size_t)NP_TOK + (size_t)nb * 64 : (size_t)nb * 2048; SCAN_ISSUE_AT(nrow0, nh, 0); }
            __syncthreads();
            { const int mat = wave >> 2, mt = wave & 3, fr = lane & 15, fq = lane >> 4;
              const LAS bf16_t* src = (mat ? sAD : sTW) + (16 * mt + fr) * 72 + 8 * fq;
              const bf16x8 a0f = *(const LAS bf16x8*)src, a1f = *(const LAS bf16x8*)(src + 32);
#pragma unroll
              for (int nt = 0; nt < 4; ++nt) {
                  const bf16x8 b0f = lw0[nt], b1f = lw1[nt];
                  f32x4 acc = (f32x4){0.f, 0.f, 0.f, 0.f};
                  acc = __builtin_amdgcn_mfma_f32_16x16x32_bf16(a0f, b0f, acc, 0, 0, 0);
                  acc = __builtin_amdgcn_mfma_f32_16x16x32_bf16(a1f, b1f, acc, 0, 0, 0);
                  const float bs = lbias[nt]; const int chn = 16 * nt + fr;
#pragma unroll
                  for (int j = 0; j < 4; ++j) { const int tok = 16 * mt + 4 * fq + j; const float pre_ = bs + acc[j]; float o;
                      if (mat == 0) o = __expf(-0.60653065971f * fast_sigmoid(pre_));
                      else o = fast_sigmoid(pre_);
                      (mat ? sB : sW)[tok * TS + chn] = o; } } }
            __syncthreads();
            { LAS float* sT = (LAS float*)(C.lds + L_T); float gacc = 1.f;
#pragma unroll
              for (int i8 = 0; i8 < 8; ++i8) { const int o = (8 * wave + i8) * TS + lane; gacc *= sW[o]; sW[o] = gacc; }
              sT[wave * 64 + lane] = gacc; }
            __syncthreads();
            { const int cq = lane & 15; const f32x4 kkc = *(const LAS f32x4*)(C.lds + L_KC + 16 * cq), kac = *(const LAS f32x4*)(C.lds + L_KC + 256 + 16 * cq), rkc = *(const LAS f32x4*)(C.lds + L_KC + 512 + 16 * cq);
              const LAS float* sT = (const LAS float*)(C.lds + L_T); f32x4 P = (f32x4){1.f, 1.f, 1.f, 1.f};
              for (int w2 = 0; w2 < wave; ++w2) P = P * *(const LAS f32x4*)(sT + w2 * 64 + 4 * cq);
              if (wave == 7 && lane < 16) *(LAS f32x4*)(C.lds + L_GT + 16 * cq) = P * *(const LAS f32x4*)(sT + 7 * 64 + 4 * cq);
#pragma unroll
              for (int i2 = 0; i2 < 2; ++i2) { const int tok = 8 * wave + 4 * i2 + (lane >> 4), o = tok * TS + 4 * cq;
                  const f32x4 ks = *(const LAS f32x4*)(sK + o), al = *(const LAS f32x4*)(sB + o), r = *(const LAS f32x4*)(sR + o); const f32x4 kkr = ks * kkc;
                  const f32x4 gt = *(const LAS f32x4*)(sW + o) * P; f32x4 gp = P; if (tok & 7) gp = *(const LAS f32x4*)(sW + o - TS) * P;
                  const float n2 = rowsum16((kkr.x * kkr.x + kkr.y * kkr.y) + (kkr.z * kkr.z + kkr.w * kkr.w)); const float inv = 1.f / fmaxf(sqrtf(n2), 1e-12f); const f32x4 kk = kkr * inv;
                  const f32x4 kp = ks * (1.f + (al - 1.f) * kac);
                  const f32x4 igt = (f32x4){__builtin_amdgcn_rcpf(gt.x), __builtin_amdgcn_rcpf(gt.y), __builtin_amdgcn_rcpf(gt.z), __builtin_amdgcn_rcpf(gt.w)};
                  *(LAS f32x4*)(sA + o) = -kk * gp; *(LAS f32x4*)(sB + o) = kk * al * igt; *(LAS f32x4*)(sK + o) = kp * igt; *(LAS f32x4*)(sR + o) = r * gt;
                  const f32x4 rk = r * kp * rkc; const float bon = rowsum16((rk.x + rk.y) + (rk.z + rk.w)); if (cq == 0) sBON[tok] = bon; } }
            __syncthreads();
            { const LAS float* pb = sR + 4 * jq; const LAS float* pv = sV + i; LAS float* pY = sY + il;
#define SCAN_LOAD(o, t) do { o.r = *(const LAS f32x4*)(pb + (t) * TS); o.k = *(const LAS f32x4*)(pb + (t) * TS + 64); \
                  o.a = *(const LAS f32x4*)(pb + (t) * TS + 256); o.b = *(const LAS f32x4*)(pb + (t) * TS + 320); o.v = pv[(t) * TS]; } while (0)
#define VMUL(d, x, y) asm("v_mul_f32 %0, %1, %2" : "=v"(d) : "v"(x), "v"(y))
#define VFMA(d, x, y, z) asm("v_fma_f32 %0, %1, %2, %3" : "=v"(d) : "v"(x), "v"(y), "v"(z))
              ScanOps cur, nx1; SCAN_LOAD(cur, 0); SCAN_LOAD(nx1, 1);
              const bool hi8 = (jq & 8) != 0, hi4 = (jq & 4) != 0; LAS float* pYq = sY + il + 32 * (((jq >> 2) & 1) * 2 + (jq >> 3));
#define SCAN_STEP(QV, TT) do { ScanOps nxt; const int tn = (TT) < 62 ? (TT) + 2 : 63; SCAN_LOAD(nxt, tn); \
                  float p; VMUL(p, s0, cur.a.x); VFMA(p, s1, cur.a.y, p); VFMA(p, s2, cur.a.z, p); VFMA(p, s3, cur.a.w, p); \
                  float u0, u1, u2, u3; \
                  VFMA(u0, cur.v, cur.k.x, s0); VFMA(u1, cur.v, cur.k.y, s1); VFMA(u2, cur.v, cur.k.z, s2); VFMA(u3, cur.v, cur.k.w, s3); \
                  const float sa = rowsum16(p); \
                  VFMA(s0, sa, cur.b.x, u0); VFMA(s1, sa, cur.b.y, u1); VFMA(s2, sa, cur.b.z, u2); VFMA(s3, sa, cur.b.w, u3); \
                  VMUL(QV, s0, cur.r.x); VFMA(QV, s1, cur.r.y, QV); VFMA(QV, s2, cur.r.z, QV); VFMA(QV, s3, cur.r.w, QV); \
                  cur = nx1; nx1 = nxt; } while (0)
#pragma unroll 1
              for (int t0 = 0; t0 < 64; t0 += 4) {
                  float q0, q1, q2, q3;
                  SCAN_STEP(q0, t0); SCAN_STEP(q1, t0 + 1); SCAN_STEP(q2, t0 + 2); SCAN_STEP(q3, t0 + 3);
                  float x01 = hi8 ? q1 : q0; const float y01 = hi8 ? q0 : q1; x01 += dpp_f<0x128>(y01);
                  float x23 = hi8 ? q3 : q2; const float y23 = hi8 ? q2 : q3; x23 += dpp_f<0x128>(y23);
                  float x = hi4 ? x23 : x01; const float yy = hi4 ? x01 : x23; x += dpp_f<0x141>(yy);
                  x += dpp_f<0xB1>(x); x += dpp_f<0x4E>(x);
                  pYq[t0 * 32] = x;
              }
              { const f32x4 gT = *(const LAS f32x4*)(C.lds + L_GT + 16 * jq); s0 *= gT.x; s1 *= gT.y; s2 *= gT.z; s3 *= gT.w; } }
#undef SCAN_STEP
            __syncthreads();
            { const int r4i = (tid & 7) * 4; const f32x4 y4 = *(const LAS f32x4*)(sY + tt * 32 + r4i);
              { u32x2 yw; yw.x = pkbf(y4.x, y4.y); yw.y = pkbf(y4.z, y4.w); *(u32x2*)(C.Yraw + (row0 + ch * 64 + tt) * 1024 + h * 64 + half * 32 + r4i) = yw; }
              if (half == 0 && tid < 64) C.bonus[(row0 + ch * 64 + tid) * 16 + h] = sBON[tid]; }
        }
        *(f32x4*)(C.out + (sample ? O_WKVS : O_WKVP) + ((size_t)(b * 16 + h) * 64 + i) * 64 + 4 * jq) = (f32x4){s0, s1, s2, s3};
        __syncthreads();
    }
#undef SCAN_ISSUE
#undef SCAN_ISSUE_AT
#undef SCAN_LOAD
#undef VMUL
#undef VFMA
}

constexpr int L_KS = 0, L_VT = 27648, L_OW = 53248;
__device__ __forceinline__ void load8(const Ctx& C, bool sample, bool isV, int b, int kvh, size_t qrow0, int key, int kmin, int c8, unsigned (&w)[4]) {
    if (key < kmin) { w[0] = w[1] = w[2] = w[3] = 0u; return; }
    if (sample && key < 128) { const float* src = (isV ? C.cache_v : C.cache_k) + ((size_t)(b * 128 + key) * 4 + kvh) * 64 + c8;
        const f32x4 s0 = *(const f32x4*)src, s1 = *(const f32x4*)(src + 4);
        w[0] = pkbf(s0.x, s0.y); w[1] = pkbf(s0.z, s0.w); w[2] = pkbf(s1.x, s1.y); w[3] = pkbf(s1.z, s1.w); return; }
    const u32x4 v = *(const u32x4*)(C.Z + (qrow0 + key - 128) * ZW + (isV ? ZVB : ZKB) + kvh * 64 + c8);
    w[0] = v.x; w[1] = v.y; w[2] = v.z; w[3] = v.w;
}
__device__ __forceinline__ void attn_item(const Ctx& C, int item) {
    const int tid = C.tid, lane = C.lane, wave = C.wave, fr = lane & 15, fq = lane >> 4;
    const bool sample = item >= 1024; int b, c, kvh;
    if (!sample) { b = item >> 7; c = (item >> 2) & 31; kvh = item & 3; } else { const int s = item - 1024; b = s >> 2; kvh = s & 3; c = 2; }
    const size_t qrow0 = sample ? (size_t)NP_TOK + (size_t)b * 64 : (size_t)b * 2048 + (size_t)c * 64;
    const int kmin = sample ? 0 : (c >= 2 ? 0 : 128 - c * 64);
    LAS bf16_t* Ks = (LAS bf16_t*)(C.lds + L_KS); LAS bf16_t* Vt = (LAS bf16_t*)(C.lds + L_VT);
    for (int p = tid; p < 1536; p += 512) {
        unsigned w[4];
        { const int key = p >> 3, c8 = (p & 7) * 8; load8(C, sample, false, b, kvh, qrow0, key, kmin, c8, w);
          *(LAS u32x4*)(Ks + key * 72 + c8) = (u32x4){w[0], w[1], w[2], w[3]}; }
        { const int key = p % 192, d0 = (p / 192) * 8; load8(C, sample, true, b, kvh, qrow0, key, kmin, d0, w);
#pragma unroll
          for (int e = 0; e < 4; ++e) { Vt[(d0 + 2 * e) * 200 + key] = (bf16_t)(w[e] & 0xffffu); Vt[(d0 + 2 * e + 1) * 200 + key] = (bf16_t)(w[e] >> 16); } }
    }
    __syncthreads();
    const int gq = wave >> 1, qh = wave & 1, hq = kvh * 4 + gq;
    const float slope = exp2f(-0.5f * (float)(hq + 1)), sink = C.sinks[hq];
#pragma unroll 1
    for (int nt = 0; nt < 2; ++nt) {
        bf16x8 qf[2];
#pragma unroll
        for (int ks = 0; ks < 2; ++ks) qf[ks] = *(const bf16x8*)(C.Z + (qrow0 + qh * 32 + nt * 16 + fr) * ZW + ZQ + hq * 64 + ks * 32 + 8 * fq);
        f32x4 sacc[12];
#pragma unroll
        for (int kt = 0; kt < 12; ++kt) sacc[kt] = (f32x4){0.f, 0.f, 0.f, 0.f};
#pragma unroll
        for (int kt = 0; kt < 12; ++kt)
#pragma unroll
            for (int ks = 0; ks < 2; ++ks) { const bf16x8 kf = *(const LAS bf16x8*)(Ks + (16 * kt + fr) * 72 + ks * 32 + 8 * fq);
                sacc[kt] = __builtin_amdgcn_mfma_f32_16x16x32_bf16(kf, qf[ks], sacc[kt], 0, 0, 0); }
        bf16x8 pf[6];
        { const float fd = (float)(qh * 32 + nt * 16 + fr + 128 - 4 * fq); float mx = -1e30f;
#pragma unroll
          for (int kt = 0; kt < 12; ++kt)
#pragma unroll
              for (int j = 0; j < 4; ++j) sacc[kt][j] = __builtin_fmaf(-slope, fabsf(fd - (float)(16 * kt + j)), sacc[kt][j]);
          if (kmin > 0) {
#pragma unroll
              for (int kt = 0; kt < 12; ++kt)
#pragma unroll
                  for (int j = 0; j < 4; ++j) { const int key = 16 * kt + 4 * fq + j; sacc[kt][j] = key >= kmin ? sacc[kt][j] : -1e30f; } }
#pragma unroll
          for (int kt = 0; kt < 12; ++kt)
#pragma unroll
              for (int j = 0; j < 4; ++j) mx = fmaxf(mx, sacc[kt][j]);
          mx = fmaxf(mx, __shfl_xor(mx, 16)); mx = fmaxf(mx, __shfl_xor(mx, 32)); mx = fmaxf(mx, sink);
          float sum = 0.f;
#pragma unroll
          for (int kt = 0; kt < 12; ++kt)
#pragma unroll
              for (int j = 0; j < 4; ++j) { const float e = __expf(sacc[kt][j] - mx); sacc[kt][j] = e; sum += e; }
          sum += __shfl_xor(sum, 16); sum += __shfl_xor(sum, 32);
          const float inv = 1.f / (sum + __expf(sink - mx));
#pragma unroll
          for (int kb = 0; kb < 6; ++kb) { const f32x4 e0 = sacc[2 * kb] * inv, e1 = sacc[2 * kb + 1] * inv;
              const u32x4 w = (u32x4){pkbf(e0[0], e0[1]), pkbf(e0[2], e0[3]), pkbf(e1[0], e1[1]), pkbf(e1[2], e1[3])}; pf[kb] = __builtin_bit_cast(bf16x8, w); }
        }
        f32x4 o[4];
#pragma unroll
        for (int nb = 0; nb < 4; ++nb) o[nb] = (f32x4){0.f, 0.f, 0.f, 0.f};
#pragma unroll
        for (int kb = 0; kb < 6; ++kb)
#pragma unroll
            for (int nb = 0; nb < 4; ++nb) { const LAS bf16_t* vp = Vt + (16 * nb + fr) * 200 + 32 * kb + 4 * fq;
                const u32x2 v0 = *(const LAS u32x2*)vp, v1 = *(const LAS u32x2*)(vp + 16);
                const bf16x8 vf = __builtin_bit_cast(bf16x8, ((u32x4){v0.x, v0.y, v1.x, v1.y}));
                o[nb] = __builtin_amdgcn_mfma_f32_16x16x32_bf16(pf[kb], vf, o[nb], 0, 0, 0); }
        { LAS float* Ow = (LAS float*)(C.lds + L_OW) + wave * (16 * 68);
#pragma unroll
          for (int nb = 0; nb < 4; ++nb)
#pragma unroll
              for (int j = 0; j < 4; ++j) Ow[(4 * fq + j) * 68 + 16 * nb + fr] = o[nb][j];
          const int qq = lane >> 2, dc = (lane & 3) * 16; const size_t tok = qrow0 + qh * 32 + 16 * nt + qq;
          const u32x4 g0 = *(const u32x4*)(C.Z + tok * ZW + ZGB + hq * 64 + dc), g1 = *(const u32x4*)(C.Z + tok * ZW + ZGB + hq * 64 + dc + 8);
          const LAS f32x4* orow = (const LAS f32x4*)(Ow + qq * 68 + dc); const f32x4 o0 = orow[0], o1 = orow[1], o2 = orow[2], o3 = orow[3];
          u32x4 w0, w1;
          w0.x = pkbf(o0.x * bflo(g0.x), o0.y * bfhi(g0.x)); w0.y = pkbf(o0.z * bflo(g0.y), o0.w * bfhi(g0.y)); w0.z = pkbf(o1.x * bflo(g0.z), o1.y * bfhi(g0.z)); w0.w = pkbf(o1.z * bflo(g0.w), o1.w * bfhi(g0.w));
          w1.x = pkbf(o2.x * bflo(g1.x), o2.y * bfhi(g1.x)); w1.y = pkbf(o2.z * bflo(g1.y), o2.w * bfhi(g1.y)); w1.z = pkbf(o3.x * bflo(g1.z), o3.y * bfhi(g1.z)); w1.w = pkbf(o3.z * bflo(g1.w), o3.w * bfhi(g1.w));
          bf16_t* yp = C.Ya + tok * 2048 + 1024 + hq * 64 + dc; *(u32x4*)yp = w0; *(u32x4*)(yp + 8) = w1; }
    }
    __syncthreads();
}
__device__ __forceinline__ void phase3(const Ctx& C) {
    for (int it = C.bid; it < 1152; it += C.G) attn_item(C, it);
    const int gw = C.bid * 8 + C.wave, NGW = C.G * 8, lane = C.lane;
    for (int wi0 = gw; wi0 < MTOK * 16 / 4; wi0 += 4 * NGW) {
        u32x2 yc[4]; f32x4 y4[4]; u32x2 vc[4], vp[4], gc[4]; float bon[4];
#pragma unroll
        for (int u = 0; u < 4; ++u) { const int wi = wi0 + u * NGW; if (wi < MTOK * 16 / 4) {
            const int pr = wi * 4 + (lane >> 4), tok = pr >> 4, h = pr & 15, col = h * 64 + 4 * (lane & 15); const bf16_t* zr = C.Z + (size_t)tok * ZW;
            yc[u] = __builtin_nontemporal_load((const u32x2*)(C.Yraw + (size_t)tok * 1024 + col)); vc[u] = *(const u32x2*)(zr + ZV + col); vp[u] = *(const u32x2*)(zr - (tok > 0 ? ZW : 0) + ZV + col);
            gc[u] = *(const u32x2*)(zr + ZGA + col); bon[u] = C.bonus[(size_t)tok * 16 + h]; } }
#pragma unroll
        for (int u = 0; u < 4; ++u) { const int wi = wi0 + u * NGW; if (wi < MTOK * 16 / 4) {
            const int pr = wi * 4 + (lane >> 4), tok = pr >> 4, h = pr & 15, col = h * 64 + 4 * (lane & 15);
            y4[u] = (f32x4){bflo(yc[u].x), bfhi(yc[u].x), bflo(yc[u].y), bfhi(yc[u].y)};
            const float mean = rowsum16((y4[u].x + y4[u].y) + (y4[u].z + y4[u].w)) * (1.f / 64.f); const f32x4 d = y4[u] - mean;
            const float var = rowsum16((d.x * d.x + d.y * d.y) + (d.z * d.z + d.w * d.w)) * (1.f / 64.f); const float rstd = rsqrtf(var + 64e-5f);
            const f32x4 v = (f32x4){bflo(vc[u].x), bfhi(vc[u].x), bflo(vc[u].y), bfhi(vc[u].y)}; f32x4 pv = (f32x4){bflo(vp[u].x), bfhi(vp[u].x), bflo(vp[u].y), bfhi(vp[u].y)};
            const int tin = tok < NP_TOK ? (tok & 2047) : ((tok - NP_TOK) & 63);
            if (tin == 0) { if (tok >= NP_TOK) pv = *(const f32x4*)(C.state_shift + (size_t)((tok - NP_TOK) >> 6) * SHIFT_W + 2048 + col); else pv = (f32x4){0.f, 0.f, 0.f, 0.f}; }
            const f32x4 mu4 = *(const f32x4*)(C.mu + 2048 + col); const f32x4 vs = v + mu4 * (pv - v);
            const f32x4 g4 = (f32x4){bflo(gc[u].x), bfhi(gc[u].x), bflo(gc[u].y), bfhi(gc[u].y)};
            const f32x4 lw = *(const f32x4*)(C.lnx_w + col), lb = *(const f32x4*)(C.lnx_b + col);
            const f32x4 o = (d * rstd * lw + lb + vs * bon[u]) * g4;
            u32x2 w; w.x = pkbf(o.x, o.y); w.y = pkbf(o.z, o.w); *(u32x2*)(C.Ya + (size_t)tok * 2048 + col) = w; } }
    }
}

__device__ __forceinline__ void phase6(const Ctx& C) {
    const int gw = C.bid * 8 + C.wave, NGW = C.G * 8;
    int m = gw; u32x4 v[4], vn[4];
    if (m >= MTOK) return;
    { const u32x4* xr = (const u32x4*)(C.out + (size_t)m * DM) + C.lane;
#pragma unroll
      for (int j = 0; j < 4; ++j) v[j] = xr[64 * j]; }
    for (;;) { const int mn = m + NGW; const bool more = mn < MTOK;
        if (more) { const u32x4* xn = (const u32x4*)(C.out + (size_t)mn * DM) + C.lane;
#pragma unroll
            for (int j = 0; j < 4; ++j) vn[j] = xn[64 * j]; }
        f32x4 f[4][2]; float s = 0.f;
#pragma unroll
        for (int j = 0; j < 4; ++j) { f[j][0] = (f32x4){bflo(v[j].x), bfhi(v[j].x), bflo(v[j].y), bfhi(v[j].y)}; f[j][1] = (f32x4){bflo(v[j].z), bfhi(v[j].z), bflo(v[j].w), bfhi(v[j].w)};
            s += (f[j][0].x * f[j][0].x + f[j][0].y * f[j][0].y) + (f[j][0].z * f[j][0].z + f[j][0].w * f[j][0].w) + (f[j][1].x * f[j][1].x + f[j][1].y * f[j][1].y) + (f[j][1].z * f[j][1].z + f[j][1].w * f[j][1].w); }
        const float rs = rsqrtf(wave_sum(s) * (1.f / DM) + 1e-6f);
        const f32x4* gr = (const f32x4*)C.g_final + 2 * C.lane; f32x4* orow = (f32x4*)(C.out + (size_t)m * DM) + 2 * C.lane;
#pragma unroll
        for (int j = 0; j < 4; ++j) { orow[128 * j] = f[j][0] * rs * gr[128 * j]; orow[128 * j + 1] = f[j][1] * rs * gr[128 * j + 1]; }
        if (!more) break;
#pragma unroll
        for (int j = 0; j < 4; ++j) v[j] = vn[j];
        m = mn; }
}

#define XB_TMO      128
#define XB_XCNT(j)  (256  + 64 * (j))
#define XB_XSUB(j)  (1280 + 64 * (j))
#define XB_XGEN(j)  (2304 + 64 * (j))
#define XB_TOP      3328
#define XB_TOPGEN   3392
#define XCD_BAR_WORDS 3456
#define XB_SPIN_CAP (1u << 18)

__device__ __forceinline__ unsigned xb_ld(unsigned* p)              { return __hip_atomic_load(p, __ATOMIC_RELAXED, __HIP_MEMORY_SCOPE_AGENT); }
__device__ __forceinline__ unsigned xb_add(unsigned* p, unsigned v) { return __hip_atomic_fetch_add(p, v, __ATOMIC_RELAXED, __HIP_MEMORY_SCOPE_AGENT); }
__device__ __forceinline__ unsigned xb_xcc_id() { return (unsigned)__builtin_amdgcn_s_getreg((3 << 11) | 20) & 0xFu; }
#define XB_SPIN(cond, bar) do { unsigned _sp = 0; while (cond) { __builtin_amdgcn_s_sleep(1); \
    if ((++_sp & 255u) == 0u) { if (xb_ld(&(bar)[XB_TMO])) break; if (_sp > XB_SPIN_CAP) { atomicAdd(&(bar)[XB_TMO], 1u); break; } } } } while (0)

struct XcdBarrier {
    unsigned* bar; unsigned x;
    volatile LAS unsigned* st;
};

__device__ __forceinline__ XcdBarrier xcd_barrier_post(unsigned* bar, volatile LAS unsigned* st) {
    XcdBarrier b; b.bar = bar; b.x = xb_xcc_id(); b.st = st;
    if (threadIdx.x == 0) (void)xb_add(&bar[XB_XCNT(b.x)], 1u);
    return b;
}
__device__ __forceinline__ void xcd_barrier_complete(unsigned* bar, unsigned x, unsigned& nloc, unsigned& nx) {
    const unsigned G = gridDim.x * gridDim.y * gridDim.z;
    unsigned sum, cnt, mine, sp = 0u;
    for (;;) {
        sum = 0u; cnt = 0u; mine = 0u;
#pragma unroll
        for (unsigned j = 0; j < 16; ++j) { const unsigned c = xb_ld(&bar[XB_XCNT(j)]); sum += c; cnt += (c > 0u) ? 1u : 0u; mine = (j == x) ? c : mine; }
        if (sum == G) break;
        __builtin_amdgcn_s_sleep(1);
        if ((++sp & 255u) == 0u) { if (xb_ld(&bar[XB_TMO])) break; if (sp > XB_SPIN_CAP) { atomicAdd(&bar[XB_TMO], 1u); break; } }
    }
    nloc = mine > 0u ? mine : 1u; nx = cnt > 0u ? cnt : 1u;
}

__device__ __forceinline__ void xcd_barrier(const XcdBarrier& b) {
    asm volatile("s_waitcnt vmcnt(0)" ::: "memory");
    __syncthreads();
    if (threadIdx.x == 0) {
        unsigned* bar = b.bar;
        __builtin_amdgcn_s_waitcnt(0);
        unsigned nloc = b.st[0], nx = b.st[1];
        if (nloc == 0u) { xcd_barrier_complete(bar, b.x, nloc, nx); b.st[0] = nloc; b.st[1] = nx; }
        const unsigned old = xb_add(&bar[XB_XSUB(b.x)], 1u);
        const unsigned gen = old / nloc;
        if (old + 1u == (gen + 1u) * nloc) {
            __builtin_amdgcn_fence(__ATOMIC_RELEASE, "agent");
            asm volatile("s_waitcnt vmcnt(0)" ::: "memory");
            const unsigned og = xb_add(&bar[XB_TOP], 1u);
            const unsigned tg = og / nx;
            if (og + 1u == (tg + 1u) * nx) xb_add(&bar[XB_TOPGEN], 1u);
            else XB_SPIN(xb_ld(&bar[XB_TOPGEN]) == tg, bar);
            __builtin_amdgcn_fence(__ATOMIC_ACQUIRE, "agent");
            xb_add(&bar[XB_XGEN(b.x)], 1u);
            asm volatile("s_waitcnt vmcnt(0)" ::: "memory");
        } else {
            XB_SPIN(xb_ld(&bar[XB_XGEN(b.x)]) == gen, bar);
            __builtin_amdgcn_fence(__ATOMIC_ACQUIRE, "agent");
            asm volatile("s_waitcnt vmcnt(0)" ::: "memory");
        }
    }
    __syncthreads();
}

__global__ void __launch_bounds__(512, 2) mega_fwd(Args a) {
    extern __shared__ __attribute__((aligned(16))) unsigned char lds_raw[];
    cg::grid_group grid = cg::this_grid();
    Ctx C;
    C.x_prompt = a.in[0]; C.x_sample = a.in[1]; C.state_wkv = a.in[2]; C.state_shift = a.in[3]; C.cache_k = a.in[4]; C.cache_v = a.in[5]; C.g_norm = a.in[6]; C.w_in = a.in[7];
    C.mu = a.in[8]; C.w0 = a.in[9]; C.w_w_up = a.in[10]; C.a0 = a.in[11]; C.w_a_up = a.in[12]; C.k_k = a.in[13]; C.k_a = a.in[14]; C.r_k = a.in[15]; C.lnx_w = a.in[16]; C.lnx_b = a.in[17];
    C.sinks = a.in[18]; C.p_a = a.in[19]; C.p_b = a.in[20]; C.w_o = a.in[21]; C.g_final = a.in[22];
    C.out = a.out; C.ws = a.ws;
    C.WinT = (bf16_t*)(a.ws + WS_WIN); C.PaT = (bf16_t*)(a.ws + WS_PA); C.PbT = (bf16_t*)(a.ws + WS_PB); C.WoT = (bf16_t*)(a.ws + WS_WO);
    C.WwT = (bf16_t*)(a.ws + WS_WW); C.WaT = (bf16_t*)(a.ws + WS_WA); C.bonus = (float*)(a.ws + WS_BON); C.Z = (bf16_t*)(a.ws + WS_Z);
    C.H = (bf16_t*)((unsigned char*)a.out + DO_H); C.Yraw = (bf16_t*)((unsigned char*)a.out + DO_YRAW); C.Ya = (bf16_t*)((unsigned char*)a.out + DO_YA); C.Yb = (bf16_t*)((unsigned char*)a.out + DO_YB);
    C.lds = (LAS unsigned char*)lds_raw;
    C.tid = threadIdx.x; C.lane = C.tid & 63; C.wave = __builtin_amdgcn_readfirstlane(C.tid >> 6); C.G = gridDim.x; C.bid = blockIdx.x;
    const int lo = a.ph_lo, hi = a.ph_hi;
    volatile LAS unsigned* misc = (volatile LAS unsigned*)(C.lds + L_MISC);
    if (C.tid < 2) misc[C.tid] = 0u;
    __syncthreads();
    XcdBarrier bar; bar.bar = (unsigned*)(a.ws + WS_BAR); bar.x = 0; bar.st = nullptr;
    if (hi - lo > 1) bar = xcd_barrier_post((unsigned*)(a.ws + WS_BAR), misc);
    if (lo > hi) grid.sync();
#define IN(k) (lo <= (k) && (k) < hi)
#define SEAM(k) do { if (IN(k) && IN((k) + 1)) xcd_barrier(bar); } while (0)
    if (IN(0)) phase0(C);
    SEAM(0);
    if (IN(1)) { pg8::Gemm g{C.H, C.WinT, MTOK, ZW, DM, DM}; pg8::StaticOrder S; S.init(MTOK, ZW, C.G, C.bid); EpiZ E{C.Z};
        pg8::gemm_phase<EpiZ, pg8::StaticOrder, true, true>(C.lds, g, S, E);
        { const int first = (72 * 43) % C.G, nidle = C.G - first; if (C.bid >= first) tr_run(C, (LAS float*)(C.lds + C.wave * 16384), (C.bid - first) * 8 + C.wave, nidle * 8, 1); } }
    SEAM(1);
    if (IN(2)) scan_phase(C);
    SEAM(2);
    if (IN(3)) phase3(C);
    SEAM(3);
    if (IN(4)) {
        { pg8::Gemm g{C.Ya, C.PaT, MTOK, DM, 2048, 2048}; pg8::StaticOrder S; S.init(MTOK, DM, C.G, C.bid); EpiMergeK E{C.Z};
          pg8::gemm_phase<EpiMergeK, pg8::StaticOrder, true, true>(C.lds, g, S, E); }
    }
    SEAM(4);
    if (IN(5)) { pg8::Gemm g{C.Z + ZMB, C.WoT, MTOK, DM, DM, ZW}; pg8::StaticOrder S; S.init(MTOK, DM, C.G, C.bid); EpiOut E{C.x_prompt, C.x_sample, C.out};
        pg8::gemm_phase<EpiOut, pg8::StaticOrder, true, true>(C.lds, g, S, E); }
    SEAM(5);
    if (IN(6)) phase6(C);
#undef IN
#undef SEAM
}

extern "C" void kernel_launch(void* const* d_in, const int* in_sizes, int n_in, void* d_out, int out_size, void* d_ws, size_t ws_size, hipStream_t stream) {
    static int grid = 0;
    if (grid == 0) {
        if (n_in != 23 || (size_t)out_size != O_END || ws_size < WS_END) { fprintf(stderr, "kernel_launch: unexpected sizes: n_in %d out %d ws %zu (need %zu)\n", n_in, out_size, ws_size, (size_t)WS_END); grid = -1; return; }
        int dev = 0, cus = 0, per_cu = 0;
        if (hipGetDevice(&dev) != hipSuccess || hipDeviceGetAttribute(&cus, hipDeviceAttributeMultiprocessorCount, dev) != hipSuccess) { grid = -1; return; }
        if (hipFuncSetAttribute((const void*)mega_fwd, hipFuncAttributeMaxDynamicSharedMemorySize, LDS_BYTES) != hipSuccess) { fprintf(stderr, "kernel_launch: hipFuncSetAttribute failed\n"); grid = -1; return; }
        if (hipOccupancyMaxActiveBlocksPerMultiprocessor(&per_cu, (const void*)mega_fwd, 512, LDS_BYTES) != hipSuccess || per_cu < 1) { fprintf(stderr, "kernel_launch: occupancy query failed (%d)\n", per_cu); (void)hipGetLastError(); grid = -1; return; }
        grid = cus * per_cu;
        fprintf(stderr, "kernel_launch: %d CUs x %d = grid %d\n", cus, per_cu, grid);
    }
    if (grid < 0) return;
    if (hipMemsetAsync((char*)d_ws + WS_BAR, 0, BAR_BYTES, stream) != hipSuccess) { fprintf(stderr, "kernel_launch: hipMemsetAsync failed\n"); return; }
    Args a{};
    for (int i = 0; i < 23; ++i) a.in[i] = (const float*)d_in[i];
    a.out = (float*)d_out; a.ws = (unsigned char*)d_ws;
#if MK_MULTI
    for (int k = 0; k < NPHASE; ++k) { a.ph_lo = k; a.ph_hi = k + 1; hipLaunchKernelGGL(mega_fwd, dim3(grid), dim3(512), LDS_BYTES, stream, a); }
#else
    a.ph_lo = 0; a.ph_hi = NPHASE;
    void* args[] = {&a};
    const hipError_t e = hipLaunchCooperativeKernel((const void*)mega_fwd, dim3(grid), dim3(512), args, LDS_BYTES, stream);
    if (e != hipSuccess) fprintf(stderr, "kernel_launch: cooperative launch failed: %s (grid %d)\n", hipGetErrorString(e), grid);
#endif
}
```
